# Optimizing an MI355X kernel written in HIP

```python
import jax
import jax.numpy as jnp
from jax import lax
import numpy as np

D_MODEL = 2048
BATCH = 2
SEQ = 8192
DEPTH = 4

GRID_W = 64
HEAD_DIM = 128
NA_HEADS = 8
NA_WIN_ROWS = 8
NA_WIN_COLS = 16
NA_BIAS_ROWS = 2 * NA_WIN_ROWS - 1
NA_BIAS_COLS = 2 * NA_WIN_COLS - 1
GQA_Q_HEADS = 8
GQA_KV_HEADS = 2
Q_BLOCK = 128
ROPE_THETA = 10000.0
CONV_CH = 1024
CONV_WIDTH = 3
FFN_HIDDEN = -(-8 * D_MODEL // (3 * 256)) * 256
RMS_EPS = 1e-6

NA_WIDTH = NA_HEADS * HEAD_DIM
GQA_Q_WIDTH = GQA_Q_HEADS * HEAD_DIM
GQA_KV_WIDTH = GQA_KV_HEADS * HEAD_DIM
IN_SIZES = (NA_WIDTH, NA_WIDTH, NA_WIDTH, GQA_Q_WIDTH, GQA_KV_WIDTH, GQA_KV_WIDTH,
            CONV_CH, CONV_CH, CONV_CH, D_MODEL, D_MODEL, D_MODEL)
IN_COLS = sum(IN_SIZES)
IN_OFFSETS = tuple(int(o) for o in np.cumsum(IN_SIZES)[:-1])

kernel_name = 'hybrid_na_gqa_shortconv_encoder'


def rms_norm(x, g):
    xf = x.astype(jnp.float32)
    y = xf * lax.rsqrt(jnp.mean(xf * xf, axis=-1, keepdims=True) + RMS_EPS)
    return (y * g.astype(jnp.float32)).astype(x.dtype)


def neighbourhood_attention(q, k, v, rpb):
    bsz, s_len, n_h, d = q.shape
    rows = s_len // GRID_W
    kr = min(NA_WIN_ROWS, rows)
    kc = NA_WIN_COLS
    qg = q.reshape(bsz, rows, GRID_W, n_h, d)
    kg = k.reshape(bsz, rows, GRID_W, n_h, d)
    vg = v.reshape(bsz, rows, GRID_W, n_h, d)
    cols = jnp.arange(GRID_W)
    col_start = jnp.clip(cols - kc // 2, 0, GRID_W - kc)
    col_idx = col_start[:, None] + jnp.arange(kc)[None, :]
    dc = col_idx - cols[:, None]
    scale = d ** -0.5

    def row_step(r):
        row_start = jnp.clip(r - kr // 2, 0, rows - kr)
        k_band = lax.dynamic_slice_in_dim(kg, row_start, kr, axis=1)
        v_band = lax.dynamic_slice_in_dim(vg, row_start, kr, axis=1)
        k_nb = k_band[:, :, col_idx]
        v_nb = v_band[:, :, col_idx]
        q_row = lax.dynamic_index_in_dim(qg, r, axis=1, keepdims=False)
        dr = row_start + jnp.arange(kr) - r
        bias = rpb[:, (dr + NA_WIN_ROWS - 1)[None, :, None],
                   (dc + NA_WIN_COLS - 1)[:, None, :]]
        s = jnp.einsum('bwhd,brwchd->bhwrc', q_row, k_nb).astype(jnp.float32) * scale
        s = s + bias.astype(jnp.float32)[None]
        p = jax.nn.softmax(s.reshape(bsz, n_h, GRID_W, kr * kc), axis=-1)
        p = p.reshape(bsz, n_h, GRID_W, kr, kc).astype(v.dtype)
        return jnp.einsum('bhwrc,brwchd->bwhd', p, v_nb)

    out = lax.map(row_step, jnp.arange(rows))
    return out.transpose(1, 0, 2, 3, 4).reshape(bsz, s_len, n_h * d)


def axial_rope(x, pos_row, pos_col):
    d = x.shape[-1]
    half = d // 2
    quarter = half // 2
    inv_freq = 1.0 / (ROPE_THETA ** (jnp.arange(quarter, dtype=jnp.float32) / quarter))
    xf = x.astype(jnp.float32)

    def rot(xp, pos):
        ang = pos.astype(jnp.float32)[:, None] * inv_freq[None, :]
        c = jnp.cos(ang)[None, :, None, :]
        s = jnp.sin(ang)[None, :, None, :]
        x1, x2 = xp[..., :quarter], xp[..., quarter:]
        return jnp.concatenate([x1 * c - x2 * s, x1 * s + x2 * c], axis=-1)

    out = jnp.concatenate([rot(xf[..., :half], pos_row), rot(xf[..., half:], pos_col)], axis=-1)
    return out.astype(x.dtype)


def gqa_attention(q, k, v, q_norm_g, k_norm_g):
    bsz, s_len, n_q, d = q.shape
    n_kv = k.shape[2]
    grp = n_q // n_kv
    t = jnp.arange(s_len)
    pos_row, pos_col = t // GRID_W, t % GRID_W
    q = axial_rope(rms_norm(q, q_norm_g), pos_row, pos_col)
    k = axial_rope(rms_norm(k, k_norm_g), pos_row, pos_col)
    n_blk = s_len // Q_BLOCK
    qb = q.reshape(bsz, n_blk, Q_BLOCK, n_kv, grp, d).transpose(1, 0, 2, 3, 4, 5)
    scale = d ** -0.5

    def block_step(q_blk):
        s = jnp.einsum('bqkgd,bskd->bkgqs', q_blk, k).astype(jnp.float32) * scale
        p = jax.nn.softmax(s, axis=-1).astype(v.dtype)
        return jnp.einsum('bkgqs,bskd->bqkgd', p, v)

    out = lax.map(block_step, qb)
    return out.transpose(1, 0, 2, 3, 4, 5).reshape(bsz, s_len, n_q * d)


def short_conv_mixer(h, b_gate, c_gate, conv_w, conv_b):
    s_len = h.shape[1]
    u = c_gate * h
    pad = CONV_WIDTH // 2
    up = jnp.pad(u, ((0, 0), (pad, pad), (0, 0)))
    y = conv_b + sum(up[:, j:j + s_len] * conv_w[j] for j in range(CONV_WIDTH))
    return b_gate * y


def hybrid_layer(x, w_in, na_rpb, q_norm_g, k_norm_g, conv_w, conv_b, w_br_na, w_br_gqa,
                 w_br_conv, w_out, pre_mix_g, post_mix_g, pre_ffn_g, post_ffn_g,
                 w_ffn_gate, w_ffn_up, w_ffn_down):
    bsz, s_len, _ = x.shape
    h = rms_norm(x, pre_mix_g)
    proj = h @ w_in
    (na_q, na_k, na_v, g_q, g_k, g_v, cv_h, cv_bg, cv_cg,
     gate_na, gate_gqa, gate_conv) = jnp.split(proj, IN_OFFSETS, axis=-1)

    def heads(t, n):
        return t.reshape(bsz, s_len, n, HEAD_DIM)

    y_na = neighbourhood_attention(heads(na_q, NA_HEADS), heads(na_k, NA_HEADS),
                                   heads(na_v, NA_HEADS), na_rpb) @ w_br_na
    y_gqa = gqa_attention(heads(g_q, GQA_Q_HEADS), heads(g_k, GQA_KV_HEADS),
                          heads(g_v, GQA_KV_HEADS), q_norm_g, k_norm_g) @ w_br_gqa
    y_conv = short_conv_mixer(cv_h, cv_bg, cv_cg, conv_w, conv_b) @ w_br_conv
    merged = (jax.nn.sigmoid(gate_na) * y_na + jax.nn.sigmoid(gate_gqa) * y_gqa
              + jax.nn.sigmoid(gate_conv) * y_conv)
    x = x + rms_norm(merged @ w_out, post_mix_g)

    h = rms_norm(x, pre_ffn_g)
    f = (jax.nn.silu(h @ w_ffn_gate) * (h @ w_ffn_up)) @ w_ffn_down
    return x + rms_norm(f, post_ffn_g)


def setup_inputs(seed: int = 0) -> dict:
    key = jax.random.key(seed)
    ks = jax.random.split(key, 19)

    def nrm(k, shape, scale):
        return jax.random.normal(k, shape, jnp.float32) * scale

    def gain(k, shape):
        return 1.0 + nrm(k, shape, 0.05)

    L, D = DEPTH, D_MODEL
    return {
        'x': nrm(ks[0], (BATCH, SEQ, D), 1.0),
        'w_in': nrm(ks[1], (L, D, IN_COLS), D ** -0.5),
        'na_rpb': nrm(ks[2], (L, NA_HEADS, NA_BIAS_ROWS, NA_BIAS_COLS), 0.5),
        'q_norm_g': gain(ks[3], (L, HEAD_DIM)),
        'k_norm_g': gain(ks[4], (L, HEAD_DIM)),
        'conv_w': nrm(ks[5], (L, CONV_WIDTH, CONV_CH), CONV_WIDTH ** -0.5),
        'conv_b': nrm(ks[6], (L, CONV_CH), 0.02),
        'w_br_na': nrm(ks[7], (L, NA_WIDTH, D), NA_WIDTH ** -0.5),
        'w_br_gqa': nrm(ks[8], (L, GQA_Q_WIDTH, D), GQA_Q_WIDTH ** -0.5),
        'w_br_conv': nrm(ks[9], (L, CONV_CH, D), CONV_CH ** -0.5),
        'w_out': nrm(ks[10], (L, D, D), D ** -0.5),
        'pre_mix_g': gain(ks[11], (L, D)),
        'post_mix_g': gain(ks[12], (L, D)),
        'pre_ffn_g': gain(ks[13], (L, D)),
        'post_ffn_g': gain(ks[14], (L, D)),
        'w_ffn_gate': nrm(ks[15], (L, D, FFN_HIDDEN), D ** -0.5),
        'w_ffn_up': nrm(ks[16], (L, D, FFN_HIDDEN), D ** -0.5),
        'w_ffn_down': nrm(ks[17], (L, FFN_HIDDEN, D), FFN_HIDDEN ** -0.5),
    }


def reference(x, w_in, na_rpb, q_norm_g, k_norm_g, conv_w, conv_b, w_br_na, w_br_gqa,
              w_br_conv, w_out, pre_mix_g, post_mix_g, pre_ffn_g, post_ffn_g,
              w_ffn_gate, w_ffn_up, w_ffn_down):
    for l in range(DEPTH):
        x = hybrid_layer(x, w_in[l], na_rpb[l], q_norm_g[l], k_norm_g[l], conv_w[l], conv_b[l],
                         w_br_na[l], w_br_gqa[l], w_br_conv[l], w_out[l],
                         pre_mix_g[l], post_mix_g[l], pre_ffn_g[l], post_ffn_g[l],
                         w_ffn_gate[l], w_ffn_up[l], w_ffn_down[l])
    return x
```

```cpp
#include <hip/hip_runtime.h>
#include <hip/hip_bf16.h>
#include <cstdio>
#include <cstdint>
#include <cmath>
namespace pg8 {
#define PG8_LAS __attribute__((address_space(3)))
typedef unsigned short bf16_t;
typedef short bf16x8 __attribute__((ext_vector_type(8)));
typedef float f32x4 __attribute__((ext_vector_type(4)));
typedef unsigned u32x4 __attribute__((ext_vector_type(4)));
constexpr int BM = 256, BK = 64, HALF = 128, HTB = HALF * BK * 2  , STAGE_BYTES = 8 * HTB, NXCD = 8, WGM = 8;

__host__ __device__ __forceinline__ int lds_byte(int r, int c) { const int st = (r >> 4) * 2 + (c >> 5), rr = r & 15, cc = c & 31, ob = rr * 64 + cc * 2; return st * 1024 + (ob ^ (((ob >> 9) & 1) << 5)); }
__host__ __device__ __forceinline__ void stage_rc(int b, int& R, int& C) { const int st = b / 1024, sb = b % 1024, swz = sb ^ (((sb >> 9) & 1) << 5); R = (st >> 1) * 16 + swz / 64; C = (st & 1) * 32 + (swz % 64) / 2; }
__host__ __device__ __forceinline__ int perm32(int rho) { const int n = rho >> 4, i = rho & 15; return 8 * (i >> 2) + 4 * n + (i & 3); }

struct Unit { int pm, pn; };
struct Gemm { const bf16_t* A; const bf16_t* Bt; int M, N, K; };

struct StaticOrder {
    int nM, nN, nwg, G, c;
    __host__ __device__ void init(int M, int N, int G_, int c_) { nM = M / BM; nN = N / BM; nwg = nM * nN; G = G_; c = c_; }
    __host__ __device__ bool next(int i, Unit& u) const {
        const long L = (long)i * G + c; if (L >= nwg) return false;
        int wgid = (int)L; { const int q = nwg / NXCD, r = nwg % NXCD, xcd = wgid % NXCD, off = wgid / NXCD; wgid = (xcd < r ? xcd * (q + 1) : r * (q + 1) + (xcd - r) * q) + off; }
        const int nig = WGM * nN, gid = wgid / nig, fm = gid * WGM, gsz = (nM - fm) < WGM ? (nM - fm) : WGM;
        u.pm = fm + ((wgid % nig) % gsz); u.pn = (wgid % nig) / gsz; return true;
    }
    __device__ __forceinline__ void a_ready(const Unit&) const {}
    __device__ __forceinline__ void done(const Unit&) const {}
};

__device__ __forceinline__ unsigned cvt_pk_bf16(float lo, float hi) { unsigned r; asm volatile("v_cvt_pk_bf16_f32 %0, %1, %2" : "=v"(r) : "v"(lo), "v"(hi)); return r; }
typedef float f32x2 __attribute__((ext_vector_type(2)));
__device__ __forceinline__ float sigm(float v) { return __builtin_amdgcn_rcpf(1.0f + __builtin_amdgcn_exp2f(-1.4426950408889634f * v)); }
__device__ __forceinline__ float bf_lo(unsigned w) { return __uint_as_float(w << 16); }
__device__ __forceinline__ float bf_hi(unsigned w) { return __uint_as_float(w & 0xffff0000u); }
struct EpiIn {
    static constexpr bool PERM = true, AFTER_DRAIN = false;
    bf16_t* O; int ldc; int sig_pn;
    __device__ __forceinline__ void operator()(const f32x4 (&acc)[2][2][4][2], const Unit& u, int wr, int wc, int fr, int fq) const {
        const int row0 = u.pm * BM + wr * 64 + fr, col0 = u.pn * BM + wc * 32 + 8 * fq; const bool sg = u.pn >= sig_pn;
#pragma unroll
        for (int ai = 0; ai < 2; ++ai)
#pragma unroll
            for (int m = 0; m < 4; ++m) { bf16_t* rowp = O + (size_t)(row0 + ai * HALF + m * 16) * ldc + col0;
#pragma unroll
                for (int bj = 0; bj < 2; ++bj) { f32x4 v0 = acc[ai][bj][m][0], v1 = acc[ai][bj][m][1];
                    if (sg) { v0 = (f32x4){sigm(v0[0]), sigm(v0[1]), sigm(v0[2]), sigm(v0[3])}; v1 = (f32x4){sigm(v1[0]), sigm(v1[1]), sigm(v1[2]), sigm(v1[3])}; }
                    u32x4 w; w.x = cvt_pk_bf16(v0[0], v0[1]); w.y = cvt_pk_bf16(v0[2], v0[3]); w.z = cvt_pk_bf16(v1[0], v1[1]); w.w = cvt_pk_bf16(v1[2], v1[3]);
                    *(u32x4*)(rowp + bj * HALF) = w; } }
    }
};
struct EpiPlain {
    static constexpr bool PERM = true, AFTER_DRAIN = false;
    bf16_t* O; int ldc;
    __device__ __forceinline__ void operator()(const f32x4 (&acc)[2][2][4][2], const Unit& u, int wr, int wc, int fr, int fq) const {
        const int row0 = u.pm * BM + wr * 64 + fr, col0 = u.pn * BM + wc * 32 + 8 * fq;
#pragma unroll
        for (int ai = 0; ai < 2; ++ai)
#pragma unroll
            for (int m = 0; m < 4; ++m) { bf16_t* rowp = O + (size_t)(row0 + ai * HALF + m * 16) * ldc + col0;
#pragma unroll
                for (int bj = 0; bj < 2; ++bj) { const f32x4 v0 = acc[ai][bj][m][0], v1 = acc[ai][bj][m][1];
                    u32x4 w; w.x = cvt_pk_bf16(v0[0], v0[1]); w.y = cvt_pk_bf16(v0[2], v0[3]); w.z = cvt_pk_bf16(v1[0], v1[1]); w.w = cvt_pk_bf16(v1[2], v1[3]);
                    *(u32x4*)(rowp + bj * HALF) = w; } }
    }
};
struct EpiBranch {
    static constexpr bool PERM = true, AFTER_DRAIN = false;
    bf16_t* O; int ldc; const bf16_t* G; int ldg; int first;
    __device__ __forceinline__ void operator()(const f32x4 (&acc)[2][2][4][2], const Unit& u, int wr, int wc, int fr, int fq) const {
        const int row0 = u.pm * BM + wr * 64 + fr, col0 = u.pn * BM + wc * 32 + 8 * fq;
#pragma unroll
        for (int ai = 0; ai < 2; ++ai)
#pragma unroll
            for (int m = 0; m < 4; ++m) { const size_t row = (size_t)(row0 + ai * HALF + m * 16); bf16_t* rowp = O + row * ldc + col0; const bf16_t* gp = G + row * ldg + col0;
#pragma unroll
                for (int bj = 0; bj < 2; ++bj) { const f32x4 a0 = acc[ai][bj][m][0], a1 = acc[ai][bj][m][1];
                    const u32x4 g = *(const u32x4*)(gp + bj * HALF); u32x4 p = (u32x4){0u, 0u, 0u, 0u}; if (!first) p = *(const u32x4*)(rowp + bj * HALF);
                    const float r0 = a0[0] * bf_lo(g.x) + bf_lo(p.x), r1 = a0[1] * bf_hi(g.x) + bf_hi(p.x), r2 = a0[2] * bf_lo(g.y) + bf_lo(p.y), r3 = a0[3] * bf_hi(g.y) + bf_hi(p.y);
                    const float r4 = a1[0] * bf_lo(g.z) + bf_lo(p.z), r5 = a1[1] * bf_hi(g.z) + bf_hi(p.z), r6 = a1[2] * bf_lo(g.w) + bf_lo(p.w), r7 = a1[3] * bf_hi(g.w) + bf_hi(p.w);
                    u32x4 w; w.x = cvt_pk_bf16(r0, r1); w.y = cvt_pk_bf16(r2, r3); w.z = cvt_pk_bf16(r4, r5); w.w = cvt_pk_bf16(r6, r7);
                    *(u32x4*)(rowp + bj * HALF) = w; } }
    }
};
struct EpiGU {
    static constexpr bool PERM = true, AFTER_DRAIN = false;
    bf16_t* O; int ldc;
    __device__ __forceinline__ void operator()(const f32x4 (&acc)[2][2][4][2], const Unit& u, int wr, int wc, int fr, int fq) const {
        const int row0 = u.pm * BM + wr * 64 + fr, col0 = u.pn * HALF + wc * 32 + 8 * fq;
#pragma unroll
        for (int ai = 0; ai < 2; ++ai)
#pragma unroll
            for (int m = 0; m < 4; ++m) { bf16_t* rowp = O + (size_t)(row0 + ai * HALF + m * 16) * ldc + col0;
                const f32x4 g0 = acc[ai][0][m][0], g1 = acc[ai][0][m][1], u0 = acc[ai][1][m][0], u1 = acc[ai][1][m][1];
                u32x4 w; w.x = cvt_pk_bf16(g0[0] * sigm(g0[0]) * u0[0], g0[1] * sigm(g0[1]) * u0[1]); w.y = cvt_pk_bf16(g0[2] * sigm(g0[2]) * u0[2], g0[3] * sigm(g0[3]) * u0[3]);
                w.z = cvt_pk_bf16(g1[0] * sigm(g1[0]) * u1[0], g1[1] * sigm(g1[1]) * u1[1]); w.w = cvt_pk_bf16(g1[2] * sigm(g1[2]) * u1[2], g1[3] * sigm(g1[3]) * u1[3]);
                *(u32x4*)rowp = w; }
    }
};
template <class Epi, class Sched, bool ALIGN_EPI = false, bool SP2 = false>
__device__ __forceinline__ void gemm_phase(PG8_LAS unsigned char* lds, const Gemm g, const Sched& S, const Epi& E) {
    int tid_ = threadIdx.x; asm volatile("" : "+v"(tid_));
    const int tid = tid_, wid = __builtin_amdgcn_readfirstlane(tid >> 6), lane = tid & 63, wr = wid >> 2, wc = wid & 3, fr = lane & 15, fq = lane >> 4;
    const int K = g.K, nt = K / BK;
    unsigned voffA[2], voffB[2];
#pragma unroll
    for (int i = 0; i < 2; ++i) { int R, C; stage_rc(tid * 16 + i * 8192, R, C); const int Rb = Epi::PERM ? ((R & ~31) + perm32(R & 31)) : R;
        voffA[i] = (unsigned)(R * K + C) * 2u; voffB[i] = (unsigned)(Rb * K + C) * 2u; }
    const size_t kstep = (size_t)(BK * 2);
    const size_t hstep = (size_t)HALF * K * 2;
    const size_t tstep = 2 * hstep;
    const unsigned ldsw = (unsigned)wid * 1024u;
    const int aoff = lds_byte(wr * 64 + fr, fq * 8), boff = lds_byte(wc * 32 + fr, fq * 8);
#define PG8_SA(b, h) (((b) * 2 + (h)) * HTB)
#define PG8_SB(b, h) ((4 + (b) * 2 + (h)) * HTB)
#define PG8_STAGE(bufoff, gbase, voff) do { _Pragma("unroll") for (int _i = 0; _i < 2; ++_i) \
        __builtin_amdgcn_global_load_lds((const unsigned*)((const char*)(gbase) + (voff)[_i]), (PG8_LAS unsigned*)(lds + (bufoff) + ldsw + _i * 8192), 16, 0, 0); } while (0)
#define PG8_LDA(dst, b, h) do { _Pragma("unroll") for (int m = 0; m < 4; ++m) _Pragma("unroll") for (int k = 0; k < 2; ++k) dst[m][k] = *(const PG8_LAS bf16x8*)(lds + PG8_SA(b, h) + aoff + m * 2048 + k * 1024); } while (0)
#define PG8_LDB(dst, b, h) do { _Pragma("unroll") for (int n = 0; n < 2; ++n) _Pragma("unroll") for (int k = 0; k < 2; ++k) dst[n][k] = *(const PG8_LAS bf16x8*)(lds + PG8_SB(b, h) + boff + n * 2048 + k * 1024); } while (0)
#define PG8_MMA(ai, bj, At, Bt) do { __builtin_amdgcn_s_setprio(1); _Pragma("unroll") for (int m = 0; m < 4; ++m) _Pragma("unroll") for (int n = 0; n < 2; ++n) _Pragma("unroll") for (int k = 0; k < 2; ++k) \
        acc[ai][bj][m][n] = __builtin_amdgcn_mfma_f32_16x16x32_bf16(Bt[n][k], At[m][k], acc[ai][bj][m][n], 0, 0, 0); __builtin_amdgcn_s_setprio(0); } while (0)
#define PG8_WAIT_V(n) asm volatile("s_waitcnt vmcnt(" #n ")" ::: "memory")
#define PG8_WAIT_L(n) asm volatile("s_waitcnt lgkmcnt(" #n ")" ::: "memory")
#define PG8_BAR __builtin_amdgcn_s_barrier()
#define PG8_SCHED __builtin_amdgcn_sched_barrier(0)
    Unit cur, nxt; int ui = 0;
    if (!S.next(0, cur)) return;
    f32x4 acc[2][2][4][2];
#pragma unroll
    for (int a = 0; a < 2; ++a)
#pragma unroll
        for (int b = 0; b < 2; ++b)
#pragma unroll
            for (int m = 0; m < 4; ++m)
#pragma unroll
                for (int n = 0; n < 2; ++n) acc[a][b][m][n] = (f32x4){0.f, 0.f, 0.f, 0.f};
    bf16x8 At[4][2], B0[2][2], B1[2][2];
    const char* cA = (const char*)g.A + (size_t)cur.pm * tstep; const char* cB = (const char*)g.Bt + (size_t)cur.pn * tstep;
    S.a_ready(cur);
    if constexpr (SP2) {
        PG8_STAGE(PG8_SB(0, 0), cB, voffB); PG8_STAGE(PG8_SB(0, 1), cB + hstep, voffB); PG8_STAGE(PG8_SA(0, 0), cA, voffA); PG8_STAGE(PG8_SA(0, 1), cA + hstep, voffA);
        if (wr == 1) PG8_BAR;
        PG8_WAIT_V(2); PG8_BAR;
        PG8_STAGE(PG8_SB(1, 0), cB + kstep, voffB); PG8_STAGE(PG8_SA(1, 0), cA + kstep, voffA); PG8_STAGE(PG8_SB(1, 1), cB + hstep + kstep, voffB);
        PG8_WAIT_V(6); PG8_BAR;
    } else {
        PG8_STAGE(PG8_SB(0, 0), cB, voffB); PG8_STAGE(PG8_SA(0, 0), cA, voffA); PG8_STAGE(PG8_SB(0, 1), cB + hstep, voffB); PG8_STAGE(PG8_SA(0, 1), cA + hstep, voffA);
        if (wr == 1) PG8_BAR;
        PG8_WAIT_V(4); PG8_BAR;
        PG8_STAGE(PG8_SB(1, 0), cB + kstep, voffB); PG8_STAGE(PG8_SA(1, 0), cA + kstep, voffA); PG8_STAGE(PG8_SB(1, 1), cB + hstep + kstep, voffB);
        PG8_WAIT_V(6); PG8_BAR;
    }
    for (;;) {
        const bool has_next = S.next(ui + 1, nxt);
        const char* nA = has_next ? (const char*)g.A + (size_t)nxt.pm * tstep : cA; const char* nB = has_next ? (const char*)g.Bt + (size_t)nxt.pn * tstep : cB;
        for (int t = 0; t < nt; t += 2) {
            const bool last = (t == nt - 2);
            const char* a1 = cA + (size_t)(t + 1) * kstep;
            const char* a2 = last ? nA : cA + (size_t)(t + 2) * kstep; const char* b2 = last ? nB : cB + (size_t)(t + 2) * kstep;
            const char* a3 = a2 + kstep; const char* b3 = b2 + kstep;
            if (last && has_next) S.a_ready(nxt);
            if constexpr (SP2) {
            PG8_LDB(B0, 0, 0); PG8_LDB(B1, 0, 1); PG8_SCHED; PG8_LDA(At, 0, 0); PG8_STAGE(PG8_SA(1, 1), a1 + hstep, voffA);
            PG8_WAIT_V(8); PG8_WAIT_L(0); PG8_BAR; PG8_MMA(0, 0, At, B0); PG8_MMA(0, 1, At, B1); PG8_BAR; PG8_SCHED;
            PG8_LDA(At, 0, 1); PG8_STAGE(PG8_SB(0, 0), b2, voffB); PG8_STAGE(PG8_SB(0, 1), b2 + hstep, voffB); PG8_STAGE(PG8_SA(0, 0), a2, voffA);
            PG8_WAIT_V(8); PG8_WAIT_L(0); PG8_BAR; PG8_MMA(1, 0, At, B0); PG8_MMA(1, 1, At, B1); PG8_BAR; PG8_SCHED;
            PG8_LDB(B0, 1, 0); PG8_LDB(B1, 1, 1); PG8_SCHED; PG8_LDA(At, 1, 0); PG8_STAGE(PG8_SA(0, 1), a2 + hstep, voffA);
            PG8_WAIT_V(8); PG8_WAIT_L(0); PG8_BAR; PG8_MMA(0, 0, At, B0); PG8_MMA(0, 1, At, B1); PG8_BAR; PG8_SCHED;
            PG8_LDA(At, 1, 1); PG8_STAGE(PG8_SB(1, 0), b3, voffB); PG8_STAGE(PG8_SB(1, 1), b3 + hstep, voffB); PG8_STAGE(PG8_SA(1, 0), a3, voffA);
            PG8_WAIT_V(8); PG8_WAIT_L(0); PG8_BAR; PG8_MMA(1, 0, At, B0); PG8_MMA(1, 1, At, B1); PG8_BAR; PG8_SCHED;
            } else {
            PG8_LDB(B0, 0, 0); PG8_SCHED; PG8_LDA(At, 0, 0); PG8_STAGE(PG8_SA(1, 1), a1 + hstep, voffA);
            PG8_WAIT_L(8); PG8_BAR; PG8_WAIT_L(0); PG8_MMA(0, 0, At, B0); PG8_BAR; PG8_SCHED;
            PG8_LDB(B1, 0, 1); PG8_STAGE(PG8_SB(0, 0), b2, voffB);
            PG8_BAR; PG8_WAIT_L(0); PG8_MMA(0, 1, At, B1); PG8_BAR;
            PG8_LDA(At, 0, 1); PG8_STAGE(PG8_SA(0, 0), a2, voffA);
            PG8_BAR; PG8_WAIT_L(0); PG8_MMA(1, 0, At, B0); PG8_BAR; PG8_SCHED;
            PG8_STAGE(PG8_SB(0, 1), b2 + hstep, voffB);
            PG8_WAIT_V(6); PG8_BAR; PG8_MMA(1, 1, At, B1); PG8_BAR;
            PG8_LDB(B0, 1, 0); PG8_SCHED; PG8_LDA(At, 1, 0); PG8_STAGE(PG8_SA(0, 1), a2 + hstep, voffA);
            PG8_WAIT_L(8); PG8_BAR; PG8_WAIT_L(0); PG8_MMA(0, 0, At, B0); PG8_BAR; PG8_SCHED;
            PG8_LDB(B1, 1, 1); PG8_STAGE(PG8_SB(1, 0), b3, voffB);
            PG8_BAR; PG8_WAIT_L(0); PG8_MMA(0, 1, At, B1); PG8_BAR;
            PG8_LDA(At, 1, 1); PG8_STAGE(PG8_SA(1, 0), a3, voffA);
            PG8_BAR; PG8_WAIT_L(0); PG8_MMA(1, 0, At, B0); PG8_BAR; PG8_SCHED;
            PG8_STAGE(PG8_SB(1, 1), b3 + hstep, voffB);
            PG8_WAIT_V(6); PG8_BAR; PG8_MMA(1, 1, At, B1); PG8_BAR;
            }
        }
        if constexpr (ALIGN_EPI) { if (wr == 0) PG8_BAR; }
        if constexpr (!Epi::AFTER_DRAIN) { E(acc, cur, wr, wc, fr, fq); S.done(cur); }
        if (!has_next) break;
#pragma unroll
        for (int a = 0; a < 2; ++a)
#pragma unroll
            for (int b = 0; b < 2; ++b)
#pragma unroll
                for (int m = 0; m < 4; ++m)
#pragma unroll
                    for (int n = 0; n < 2; ++n) acc[a][b][m][n] = (f32x4){0.f, 0.f, 0.f, 0.f};
        cur = nxt; cA = nA; cB = nB; ++ui;
        if constexpr (ALIGN_EPI) { if (wr == 1) PG8_BAR; }
    }
    PG8_WAIT_V(0);
    if constexpr (!ALIGN_EPI) { if (wr == 0) PG8_BAR; }
    PG8_BAR;
    if constexpr (Epi::AFTER_DRAIN) { E.fused(acc, cur, wr, wc, fr, fq, lds, wid, lane); S.done(cur); }
#undef PG8_SA
#undef PG8_SB
#undef PG8_STAGE
#undef PG8_LDA
#undef PG8_LDB
#undef PG8_MMA
#undef PG8_WAIT_V
#undef PG8_WAIT_L
#undef PG8_BAR
#undef PG8_SCHED
}
}
namespace att {
#define ATT_LAS __attribute__((address_space(3)))
typedef unsigned short bf16_t;
using bf16x8 = __attribute__((ext_vector_type(8))) short;
using s16x4  = __attribute__((ext_vector_type(4))) short;
using f32x16 = __attribute__((ext_vector_type(16))) float;
using u32x4  = __attribute__((ext_vector_type(4))) unsigned;
constexpr int   D = 128, NW = 8, QBLK = 32, KVBLK = 64;
constexpr float SCALE = 0.088388347648318440f, LOG2E = 1.4426950408889634f;
constexpr float THR = 8.f;
constexpr int SHM_V = KVBLK * D * 2, SHM_K = KVBLK * D * 2;
constexpr int OFF_WS = 2 * SHM_V + 2 * SHM_K;
constexpr int OFF_TAB = OFF_WS + NW * 64 * 4;
constexpr int SHM_ATTN = OFF_TAB + 640 * 4;
constexpr float NEG = -1e30f;
#define KSWZ(row, colB) ((row) * 256 + ((colB) ^ (((row) & 7) << 4)))
#define SBAR() __builtin_amdgcn_sched_barrier(0)
__device__ __forceinline__ int crow(int r, int hi) { return (r & 3) + 8 * (r >> 2) + 4 * hi; }
__device__ __forceinline__ unsigned cvtpk(float lo, float hi) { unsigned r; asm volatile("v_cvt_pk_bf16_f32 %0, %1, %2" : "=v"(r) : "v"(lo), "v"(hi)); return r; }

template <bool LOG2>
__device__ __forceinline__ void partialSM(f32x16& p0, f32x16& p1, float& m_reg, float& mn, float& alpha) {
  constexpr float C = LOG2 ? 1.0f : SCALE * LOG2E;
  constexpr float TH = LOG2 ? THR * LOG2E : THR / SCALE;
  float pmax = p0[0];
#pragma unroll
  for (int r = 1; r < 16; ++r) pmax = fmaxf(pmax, p0[r]);
#pragma unroll
  for (int r = 0; r < 16; ++r) pmax = fmaxf(pmax, p1[r]);
  { auto rr = __builtin_amdgcn_permlane32_swap(__float_as_uint(pmax), __float_as_uint(pmax), false, false);
    pmax = fmaxf(__uint_as_float(rr[0]), __uint_as_float(rr[1])); }
  if (__builtin_expect(__all(pmax - m_reg <= TH), 1)) { mn = m_reg; alpha = 1.f; }
  else { mn = fmaxf(m_reg, pmax); alpha = __builtin_amdgcn_exp2f((m_reg - mn) * C); m_reg = mn; }
  float mnC = -mn * C;
#pragma unroll
  for (int r = 0; r < 16; ++r) p0[r] = fmaf(p0[r], C, mnC);
#pragma unroll
  for (int r = 0; r < 16; ++r) p1[r] = fmaf(p1[r], C, mnC);
#pragma unroll
  for (int r = 0; r < 16; ++r) p0[r] = __builtin_amdgcn_exp2f(p0[r]);
}
__device__ __forceinline__ void finishSM(f32x16& p0, f32x16& p1, float alpha, float& l_reg, bf16x8& pa0, bf16x8& pa1, bf16x8& pa2, bf16x8& pa3) {
#pragma unroll
  for (int r = 0; r < 16; ++r) p1[r] = __builtin_amdgcn_exp2f(p1[r]);
  float ps = 0;
#pragma unroll
  for (int r = 0; r < 16; ++r) ps += p0[r];
#pragma unroll
  for (int r = 0; r < 16; ++r) ps += p1[r];
  { auto rr = __builtin_amdgcn_permlane32_swap(__float_as_uint(ps), __float_as_uint(ps), false, false);
    ps = __uint_as_float(rr[0]) + __uint_as_float(rr[1]); }
  l_reg = l_reg * alpha + ps;
#define PK4(P, BASE, OUT) do { unsigned a0 = cvtpk(P[BASE + 0], P[BASE + 1]), a1 = cvtpk(P[BASE + 2], P[BASE + 3]);   \
    unsigned b0 = cvtpk(P[BASE + 4], P[BASE + 5]), b1 = cvtpk(P[BASE + 6], P[BASE + 7]);                              \
    auto r0 = __builtin_amdgcn_permlane32_swap(a0, b0, false, false); auto r1 = __builtin_amdgcn_permlane32_swap(a1, b1, false, false); \
    u32x4 w = {r0[0], r1[0], r0[1], r1[1]}; OUT = __builtin_bit_cast(bf16x8, w); } while (0)
  PK4(p0, 0, pa0); PK4(p0, 8, pa1); PK4(p1, 0, pa2); PK4(p1, 8, pa3);
#undef PK4
}
__device__ __forceinline__ void qkt(f32x16& p0, f32x16& p1, const ATT_LAS char* Ks, const bf16x8* qr, int r32, int hi) {
  p0 = f32x16{}; p1 = f32x16{};
#pragma unroll
  for (int d0 = 0; d0 < 8; ++d0) { int cb = (d0 * 16 + hi * 8) * 2;
    bf16x8 b0 = *reinterpret_cast<const ATT_LAS bf16x8*>(Ks + KSWZ(r32, cb));
    bf16x8 b1 = *reinterpret_cast<const ATT_LAS bf16x8*>(Ks + KSWZ(32 + r32, cb));
    p0 = __builtin_amdgcn_mfma_f32_32x32x16_bf16(b0, qr[d0], p0, 0, 0, 0);
    p1 = __builtin_amdgcn_mfma_f32_32x32x16_bf16(b1, qr[d0], p1, 0, 0, 0); }
}
__device__ __forceinline__ void na_hook(f32x16& p0, f32x16& p1, int kr, int qrow, int rs, int csrel, const ATT_LAS float* tabq) {
  constexpr float C = SCALE * LOG2E;
  const bool rowvalid = (kr >= rs) && (kr < rs + 8);
  if (!rowvalid) {
#pragma unroll
    for (int r = 0; r < 16; ++r) { p0[r] = NEG; p1[r] = NEG; }
  } else {
    const ATT_LAS float* tb = tabq + (kr - qrow + 7) * 32;
#pragma unroll
    for (int r = 0; r < 16; ++r) { const int kc = (r & 3) + 8 * (r >> 2);
      const float b0 = tb[kc], b1 = tb[32 + kc];
      p0[r] = ((unsigned)(kc + csrel) < 16u) ? fmaf(p0[r], C, b0) : NEG;
      p1[r] = ((unsigned)(kc + 32 + csrel) < 16u) ? fmaf(p1[r], C, b1) : NEG; }
  }
}
__device__ __forceinline__ int v_st(int k, int c) { const int kk = (k & ~0xC) | ((k & 4) << 1) | ((k & 8) >> 1); return ((kk >> 3) * 4 + (c >> 5)) * 512 + ((kk & 7) * 32 + (c & 31)) * 2; }
__device__ __forceinline__ int v_rd_base(int lane) { return ((lane & 3) << 3) | (((lane >> 2) & 3) << 6) | (((lane >> 4) & 1) << 5) | (((lane >> 5) & 1) << 8); }
constexpr int v_rd_off(int d0, int ks, int half) { return d0 * 512 + ks * 4096 + half * 2048; }
template <int OFF> __device__ __forceinline__ s16x4 tr_read(int vb) {
  s16x4 r; asm volatile("ds_read_b64_tr_b16 %0, %1 offset:%2" : "=&v"(r) : "v"(vb), "i"(OFF) : "memory"); return r;
}
template <int D0> __device__ __forceinline__ void pv_one(f32x16& od, int vb, bf16x8 pa0, bf16x8 pa1, bf16x8 pa2, bf16x8 pa3) {
  const s16x4 l0 = tr_read<v_rd_off(D0, 0, 0)>(vb), h0 = tr_read<v_rd_off(D0, 0, 1)>(vb), l1 = tr_read<v_rd_off(D0, 1, 0)>(vb), h1 = tr_read<v_rd_off(D0, 1, 1)>(vb);
  const s16x4 l2 = tr_read<v_rd_off(D0, 2, 0)>(vb), h2 = tr_read<v_rd_off(D0, 2, 1)>(vb), l3 = tr_read<v_rd_off(D0, 3, 0)>(vb), h3 = tr_read<v_rd_off(D0, 3, 1)>(vb);
  asm volatile("s_waitcnt lgkmcnt(0)" ::: "memory"); SBAR();
#define PK(L, H) (bf16x8){L[0], L[1], L[2], L[3], H[0], H[1], H[2], H[3]}
  od = __builtin_amdgcn_mfma_f32_32x32x16_bf16(pa0, PK(l0, h0), od, 0, 0, 0);
  od = __builtin_amdgcn_mfma_f32_32x32x16_bf16(pa1, PK(l1, h1), od, 0, 0, 0);
  od = __builtin_amdgcn_mfma_f32_32x32x16_bf16(pa2, PK(l2, h2), od, 0, 0, 0);
  od = __builtin_amdgcn_mfma_f32_32x32x16_bf16(pa3, PK(l3, h3), od, 0, 0, 0);
#undef PK
}
__device__ __forceinline__ void pv_d0(f32x16* o, int vb, bf16x8 pa0, bf16x8 pa1, bf16x8 pa2, bf16x8 pa3) {
  pv_one<0>(o[0], vb, pa0, pa1, pa2, pa3); pv_one<1>(o[1], vb, pa0, pa1, pa2, pa3); pv_one<2>(o[2], vb, pa0, pa1, pa2, pa3); pv_one<3>(o[3], vb, pa0, pa1, pa2, pa3);
}

template <bool NA, int SDEPTH, int LDQ, int LDK, int LDO>
__device__ __forceinline__ void attn_unit(const bf16_t* __restrict__ Qb, const bf16_t* __restrict__ Kb, const bf16_t* __restrict__ Vb, bf16_t* __restrict__ Ob,
                                          int NT, int krow0, int r0, const float* __restrict__ rpb, ATT_LAS char* lds) {
  int tid_ = threadIdx.x; asm volatile("" : "+v"(tid_));
  const int tid = tid_, wid = tid >> 6, lane = tid & 63, r32 = lane & 31, hi = lane >> 5;
  ATT_LAS char* V_lds = lds; ATT_LAS char* K_lds = lds + 2 * SHM_V;
  ATT_LAS float* ws = (ATT_LAS float*)(lds + OFF_WS) + wid * 64; ATT_LAS float* li_l = ws; ATT_LAS float* al_l = ws + 32;
  ATT_LAS float* tab = (ATT_LAS float*)(lds + OFF_TAB);
  __syncthreads();
  const int qrow = r0 + (wid >> 1), qc = (wid & 1) * 32 + r32;
  const int rs = min(max(qrow - 4, 0), 120), cs = min(max(qc - 8, 0), 48), csrel = 4 * hi - cs;
  const ATT_LAS float* tabq = tab + 64 + 15 - qc + 4 * hi;
  if constexpr (NA) { for (int i = tid; i < 15 * 32; i += 64 * NW) { const int rr = i >> 5, cc = i & 31; tab[64 + i] = (cc < 31) ? rpb[rr * 31 + cc] * LOG2E : 0.f; } }
  float m_reg = NEG, l_reg = 0; f32x16 o[4] = {}; bf16x8 qr[8];
  const bf16_t* Qw = Qb + (long)(wid * QBLK + r32) * LDQ + hi * 8;
#pragma unroll
  for (int d0 = 0; d0 < 8; ++d0) qr[d0] = *reinterpret_cast<const bf16x8*>(Qw + d0 * 16);
  const int sr = tid >> 4, sc = (tid & 15) * 8, vst0 = v_st(sr, sc), vst1 = v_st(32 + sr, sc);
  const int vb0 = (int)(unsigned)(uintptr_t)V_lds + v_rd_base(lane);
  struct { bf16x8 vs0, vs1, ks0, ks1; } sr_[SDEPTH];
#define TILE_TOK(t) (NA ? (min(krow0 + (t), 127) * 64) : ((t) * 64))
  typedef const __attribute__((address_space(1))) char* gcp;
  const unsigned lof0 = (unsigned)(sr * LDK + sc) * 2u, lof1 = lof0 + 32u * LDK * 2u;
#define SLOAD(i, t) do { const long tb_ = (long)TILE_TOK(t) * (LDK * 2); gcp kt_ = (gcp)Kb + tb_; gcp vt_ = (gcp)Vb + tb_; \
    sr_[i].vs0 = *(const __attribute__((address_space(1))) bf16x8*)(vt_ + lof0); sr_[i].vs1 = *(const __attribute__((address_space(1))) bf16x8*)(vt_ + lof1); \
    sr_[i].ks0 = *(const __attribute__((address_space(1))) bf16x8*)(kt_ + lof0); sr_[i].ks1 = *(const __attribute__((address_space(1))) bf16x8*)(kt_ + lof1); } while (0)
#define SWRITE(b, i) do { *(ATT_LAS bf16x8*)(V_lds + (b) * SHM_V + vst0) = sr_[i].vs0;          \
    *(ATT_LAS bf16x8*)(V_lds + (b) * SHM_V + vst1) = sr_[i].vs1; int kc_ = sc * 2;               \
    *(ATT_LAS bf16x8*)(K_lds + (b) * SHM_K + KSWZ(sr, kc_)) = sr_[i].ks0;                       \
    *(ATT_LAS bf16x8*)(K_lds + (b) * SHM_K + KSWZ(32 + sr, kc_)) = sr_[i].ks1; } while (0)
#define SWAIT() do { if constexpr (SDEPTH == 2) asm volatile("s_waitcnt vmcnt(4)" ::: "memory"); else asm volatile("s_waitcnt vmcnt(0)" ::: "memory"); } while (0)
#define RESC(a) do { if (__any((a) < 1.f)) { if (hi == 0) al_l[r32] = (a); asm volatile("s_waitcnt lgkmcnt(0)" ::: "memory"); \
    _Pragma("unroll") for (int d = 0; d < 4; ++d) _Pragma("unroll") for (int r = 0; r < 16; ++r) o[d][r] *= al_l[crow(r, hi)]; } } while (0)
#define HOOK(P0, P1, t) do { if constexpr (NA) na_hook(P0, P1, krow0 + (t), qrow, rs, csrel, tabq); } while (0)
  f32x16 pA0, pA1, pB0, pB1; float mnA, mnB, alA, alB; bf16x8 pa0, pa1, pa2, pa3;
  constexpr int SE = 0, SO = SDEPTH - 1;
  SLOAD(SE, 0); asm volatile("s_waitcnt vmcnt(0)" ::: "memory"); SWRITE(0, SE); __syncthreads();
  qkt(pA0, pA1, K_lds, qr, r32, hi); HOOK(pA0, pA1, 0); partialSM<NA>(pA0, pA1, m_reg, mnA, alA);
  SLOAD(SO, 1); if constexpr (SDEPTH == 2) { if (2 < NT) SLOAD(SE, 2); }
  SWAIT(); SWRITE(1, SO); __syncthreads();
  for (int j = 1; j + 1 < NT; j += 2) {
    SBAR(); qkt(pB0, pB1, K_lds + SHM_K, qr, r32, hi);
    finishSM(pA0, pA1, alA, l_reg, pa0, pa1, pa2, pa3); SBAR();
    SLOAD(SO, j + SDEPTH); SBAR();
    pv_d0(o, vb0, pa0, pa1, pa2, pa3); HOOK(pB0, pB1, j); partialSM<NA>(pB0, pB1, m_reg, mnB, alB);
    __syncthreads(); SWAIT(); SWRITE(0, SE);
    RESC(alB); __syncthreads();
    SBAR(); qkt(pA0, pA1, K_lds, qr, r32, hi);
    finishSM(pB0, pB1, alB, l_reg, pa0, pa1, pa2, pa3); SBAR();
    if (SDEPTH == 1 || j + 3 < NT) SLOAD(SE, j + 1 + SDEPTH); SBAR();
    pv_d0(o, vb0 + SHM_V, pa0, pa1, pa2, pa3); HOOK(pA0, pA1, j + 1); partialSM<NA>(pA0, pA1, m_reg, mnA, alA);
    __syncthreads(); SWAIT(); SWRITE(1, SO);
    RESC(alA); __syncthreads();
  }
  SBAR(); qkt(pB0, pB1, K_lds + SHM_K, qr, r32, hi);
  finishSM(pA0, pA1, alA, l_reg, pa0, pa1, pa2, pa3); SBAR();
  pv_d0(o, vb0, pa0, pa1, pa2, pa3); HOOK(pB0, pB1, NT - 1); partialSM<NA>(pB0, pB1, m_reg, mnB, alB);
  __syncthreads(); RESC(alB);
  finishSM(pB0, pB1, alB, l_reg, pa0, pa1, pa2, pa3); SBAR();
  pv_d0(o, vb0 + SHM_V, pa0, pa1, pa2, pa3);
  if (hi == 0) li_l[r32] = l_reg; asm volatile("s_waitcnt lgkmcnt(0)" ::: "memory");
  float rli[16];
#pragma unroll
  for (int r = 0; r < 16; ++r) rli[r] = __builtin_amdgcn_rcpf(li_l[crow(r, hi)]);
  bf16_t* Ow = Ob + (long)(wid * QBLK) * LDO;
#pragma unroll
  for (int r = 0; r < 16; ++r) { const int orow = crow(r, hi);
#pragma unroll
    for (int d0 = 0; d0 < 4; ++d0) { const float v = o[d0][r] * rli[r]; Ow[(long)orow * LDO + d0 * 32 + r32] = (bf16_t)(cvtpk(v, v) & 0xffffu); } }
#undef TILE_TOK
#undef SLOAD
#undef SWRITE
#undef SWAIT
#undef RESC
#undef HOOK
}
#undef KSWZ
#undef SBAR
}
constexpr int NWAVES = 8;
constexpr int BATCH = 2, SEQ = 8192, DM = 2048, DEPTH = 4, GRIDW = 64, HD = 128;
constexpr int M = BATCH * SEQ;
constexpr int INC = 13824, FF = 5632, NGU = 2 * FF;
constexpr int C_NAQ = 0, C_NAK = 1024, C_NAV = 2048, C_GQ = 3072, C_GK = 4096, C_GV = 4352, C_CH = 4608, C_CB = 5632, C_CC = 6656, C_GNA = 7680, C_GGQ = 9728, C_GCV = 11776;
constexpr float RMS_EPS = 1e-6f;
constexpr size_t MiB = 1u << 20;
constexpr size_t WS_CTL = 0, CTL_ZERO_BYTES = 1 * MiB;
constexpr size_t WS_ROPE = 1 * MiB;
constexpr size_t WS_WIN = 2 * MiB,    SZ_WIN = 54 * MiB;
constexpr size_t WS_WBR = 218 * MiB,  SZ_WBR = 4 * MiB;
constexpr size_t WS_WOUT = 266 * MiB, SZ_WOUT = 8 * MiB;
constexpr size_t WS_WGU = 298 * MiB,  SZ_WGU = 44 * MiB;
constexpr size_t WS_WDN = 474 * MiB,  SZ_WDN = 22 * MiB;
constexpr size_t WS_H = 562 * MiB;
constexpr size_t WS_PROJ = 626 * MiB;
constexpr size_t WS_ACT = WS_PROJ;
constexpr size_t WS_ANA = 1058 * MiB, WS_AGQ = 1090 * MiB, WS_ACV = 1122 * MiB;
constexpr size_t WS_MRG = 1154 * MiB;
constexpr size_t WS_T = 1218 * MiB;
constexpr size_t WS_END = 1282 * MiB;
static_assert(SZ_WIN == (size_t)INC * DM * 2 && SZ_WGU == (size_t)NGU * DM * 2 && SZ_WDN == (size_t)DM * FF * 2 && WS_WIN + 4 * SZ_WIN == WS_WBR && WS_WBR + 12 * SZ_WBR == WS_WOUT && WS_WOUT + 4 * SZ_WOUT == WS_WGU &&
              WS_WGU + 4 * SZ_WGU == WS_WDN && WS_WDN + 4 * SZ_WDN == WS_H && WS_H + (size_t)M * DM * 2 == WS_PROJ && WS_PROJ + (size_t)M * INC * 2 == WS_ANA && WS_T + (size_t)M * DM * 2 == WS_END, "d_ws map");
constexpr int CW_BAR = 4096;
constexpr int RING_OFF = 0, RING_BYTES = 131072;
constexpr int LDSCTL_OFF = RING_BYTES, MISC_OFF = LDSCTL_OFF + 320;
constexpr int LDS_BYTES = 147456;
static_assert(att::SHM_ATTN <= RING_BYTES, "attention LDS fits the ring region");

#define GAS __attribute__((address_space(1)))
#define LAS __attribute__((address_space(3)))
typedef unsigned short bf16;
typedef unsigned v4u __attribute__((ext_vector_type(4)));
typedef unsigned v2u __attribute__((ext_vector_type(2)));
typedef float f32x4 __attribute__((ext_vector_type(4)));
typedef GAS unsigned gu32;
#define RLX_AGENT __ATOMIC_RELAXED, __HIP_MEMORY_SCOPE_AGENT
#define LDS_WAIT() asm volatile("s_waitcnt lgkmcnt(0)" ::: "memory")
#define VM_WAIT() asm volatile("s_waitcnt vmcnt(0)" ::: "memory")
__device__ __forceinline__ unsigned f2bf(float f) { unsigned u = __builtin_bit_cast(unsigned, f); return (u + 0x7fffu + ((u >> 16) & 1u)) >> 16; }
__device__ __forceinline__ unsigned pk2(float lo, float hi) { return f2bf(lo) | (f2bf(hi) << 16); }
__device__ __forceinline__ float bflo(unsigned w) { return __uint_as_float(w << 16); }
__device__ __forceinline__ float bfhi(unsigned w) { return __uint_as_float(w & 0xffff0000u); }
#define XB_TMO      128
#define XB_XCNT(j)  (256  + 64 * (j))
#define XB_XSUB(j)  (1280 + 64 * (j))
#define XB_XGEN(j)  (2304 + 64 * (j))
#define XB_TOP      3328
#define XB_TOPGEN   3392
#define XCD_BAR_WORDS 3456
#define XB_SPIN_CAP (1u << 18)

__device__ __forceinline__ unsigned xb_ld(unsigned* p)              { return __hip_atomic_load(p, __ATOMIC_RELAXED, __HIP_MEMORY_SCOPE_AGENT); }
__device__ __forceinline__ unsigned xb_add(unsigned* p, unsigned v) { return __hip_atomic_fetch_add(p, v, __ATOMIC_RELAXED, __HIP_MEMORY_SCOPE_AGENT); }
__device__ __forceinline__ unsigned xb_xcc_id() { return (unsigned)__builtin_amdgcn_s_getreg((3 << 11) | 20) & 0xFu; }
#define XB_SPIN(cond, bar) do { unsigned _sp = 0; while (cond) { __builtin_amdgcn_s_sleep(1); \
    if ((++_sp & 255u) == 0u) { if (xb_ld(&(bar)[XB_TMO])) break; if (_sp > XB_SPIN_CAP) { atomicAdd(&(bar)[XB_TMO], 1u); break; } } } } while (0)

struct XcdBarrier {
    unsigned* bar; unsigned x;
    volatile LAS unsigned* st;
};

__device__ __forceinline__ XcdBarrier xcd_barrier_post(unsigned* bar, volatile LAS unsigned* st) {
    XcdBarrier b; b.bar = bar; b.x = xb_xcc_id(); b.st = st;
    if (threadIdx.x == 0) (void)xb_add(&bar[XB_XCNT(b.x)], 1u);
    return b;
}
__device__ __forceinline__ void xcd_barrier_complete(unsigned* bar, unsigned x, unsigned& nloc, unsigned& nx) {
    const unsigned G = gridDim.x * gridDim.y * gridDim.z;
    unsigned sum, cnt, mine, sp = 0u;
    for (;;) {
        sum = 0u; cnt = 0u; mine = 0u;
#pragma unroll
        for (unsigned j = 0; j < 16; ++j) { const unsigned c = xb_ld(&bar[XB_XCNT(j)]); sum += c; cnt += (c > 0u) ? 1u : 0u; mine = (j == x) ? c : mine; }
        if (sum == G) break;
        __builtin_amdgcn_s_sleep(1);
        if ((++sp & 255u) == 0u) { if (xb_ld(&bar[XB_TMO])) break; if (sp > XB_SPIN_CAP) { atomicAdd(&bar[XB_TMO], 1u); break; } }
    }
    nloc = mine > 0u ? mine : 1u; nx = cnt > 0u ? cnt : 1u;
}

__device__ __forceinline__ void xcd_barrier(const XcdBarrier& b) {
    asm volatile("s_waitcnt vmcnt(0)" ::: "memory");
    __syncthreads();
    if (threadIdx.x == 0) {
        unsigned* bar = b.bar;
        __builtin_amdgcn_s_waitcnt(0);
        unsigned nloc = b.st[0], nx = b.st[1];
        if (nloc == 0u) { xcd_barrier_complete(bar, b.x, nloc, nx); b.st[0] = nloc; b.st[1] = nx; }
        const unsigned old = xb_add(&bar[XB_XSUB(b.x)], 1u);
        const unsigned gen = old / nloc;
        if (old + 1u == (gen + 1u) * nloc) {
            __builtin_amdgcn_fence(__ATOMIC_RELEASE, "agent");
            asm volatile("s_waitcnt vmcnt(0)" ::: "memory");
            const unsigned og = xb_add(&bar[XB_TOP], 1u);
            const unsigned tg = og / nx;
            if (og + 1u == (tg + 1u) * nx) xb_add(&bar[XB_TOPGEN], 1u);
            else XB_SPIN(xb_ld(&bar[XB_TOPGEN]) == tg, bar);
            __builtin_amdgcn_fence(__ATOMIC_ACQUIRE, "agent");
            xb_add(&bar[XB_XGEN(b.x)], 1u);
            asm volatile("s_waitcnt vmcnt(0)" ::: "memory");
        } else {
            XB_SPIN(xb_ld(&bar[XB_XGEN(b.x)]) == gen, bar);
            __builtin_amdgcn_fence(__ATOMIC_ACQUIRE, "agent");
            asm volatile("s_waitcnt vmcnt(0)" ::: "memory");
        }
    }
    __syncthreads();
}
struct Frame {
    LAS unsigned char* lds;
    volatile LAS unsigned* MISC;
    gu32* ctl;
    int tid, lane, wave;
    int vcu, G;
    unsigned char* ws;
};
__device__ __forceinline__ float wave_sum(float v) {
#pragma unroll
    for (int o = 1; o < 64; o <<= 1) v += __shfl_xor(v, o);
    return v;
}
__device__ __forceinline__ float half_sum(float v) {
#pragma unroll
    for (int o = 1; o < 32; o <<= 1) v += __shfl_xor(v, o);
    return v;
}
__device__ __forceinline__ void transpose_item(const float* __restrict__ W, int K, int N, bf16* __restrict__ WT, LAS float* scr, int k0, int n0, int drow, int lane) {
#pragma unroll 8
    for (int i = 0; i < 32; ++i) { const int kk = 2 * i + (lane >> 5); scr[kk * 33 + (lane & 31)] = W[(size_t)(k0 + kk) * N + n0 + (lane & 31)]; }
    LDS_WAIT(); asm volatile("" ::: "memory");
    const int c = lane & 7;
#pragma unroll
    for (int j = 0; j < 4; ++j) { const int n = (lane >> 3) + 8 * j; const LAS float* s = scr + (8 * c) * 33 + n;
        v4u o; o.x = pk2(s[0 * 33], s[1 * 33]); o.y = pk2(s[2 * 33], s[3 * 33]); o.z = pk2(s[4 * 33], s[5 * 33]); o.w = pk2(s[6 * 33], s[7 * 33]);
        *(GAS v4u*)(WT + (size_t)(drow + n) * K + k0 + 8 * c) = o; }
    LDS_WAIT(); asm volatile("" ::: "memory");
}
__device__ __forceinline__ void pre_row(const float* __restrict__ xrow, const float* __restrict__ g, bf16* __restrict__ hrow, int lane) {
    const GAS f32x4* xr = (const GAS f32x4*)xrow + lane; const GAS f32x4* gr = (const GAS f32x4*)g + lane;
    f32x4 v[8]; float s = 0.f;
#pragma unroll
    for (int j = 0; j < 8; ++j) { v[j] = xr[64 * j]; s += (v[j].x * v[j].x + v[j].y * v[j].y) + (v[j].z * v[j].z + v[j].w * v[j].w); }
    const float rstd = 1.0f / sqrtf(wave_sum(s) * (1.f / DM) + RMS_EPS);
    GAS v2u* o8 = (GAS v2u*)hrow + lane;
#pragma unroll
    for (int j = 0; j < 8; ++j) { const f32x4 gg = gr[64 * j]; v2u w; w.x = pk2(v[j].x * rstd * gg.x, v[j].y * rstd * gg.y); w.y = pk2(v[j].z * rstd * gg.z, v[j].w * rstd * gg.w); o8[64 * j] = w; }
}
__device__ __forceinline__ void post_row(const bf16* __restrict__ trow, const float* __restrict__ xsrc, float* __restrict__ xout, const float* __restrict__ gpost, const float* __restrict__ gnext, bf16* __restrict__ hrow, int lane) {
    const GAS v2u* tr = (const GAS v2u*)trow + lane; const GAS f32x4* xr = (const GAS f32x4*)xsrc + lane; const GAS f32x4* gp = (const GAS f32x4*)gpost + lane;
    f32x4 t[8], x[8]; float s = 0.f;
#pragma unroll
    for (int j = 0; j < 8; ++j) { const v2u w = tr[64 * j]; t[j] = (f32x4){bflo(w.x), bfhi(w.x), bflo(w.y), bfhi(w.y)}; x[j] = xr[64 * j];
        s += (t[j].x * t[j].x + t[j].y * t[j].y) + (t[j].z * t[j].z + t[j].w * t[j].w); }
    const float rstd = 1.0f / sqrtf(wave_sum(s) * (1.f / DM) + RMS_EPS);
    float s2 = 0.f; GAS f32x4* xo = (GAS f32x4*)xout + lane;
#pragma unroll
    for (int j = 0; j < 8; ++j) { const f32x4 gg = gp[64 * j]; x[j] = x[j] + t[j] * rstd * gg; xo[64 * j] = x[j];
        s2 += (x[j].x * x[j].x + x[j].y * x[j].y) + (x[j].z * x[j].z + x[j].w * x[j].w); }
    if (gnext) {
        const float rstd2 = 1.0f / sqrtf(wave_sum(s2) * (1.f / DM) + RMS_EPS);
        const GAS f32x4* gn = (const GAS f32x4*)gnext + lane; GAS v2u* o8 = (GAS v2u*)hrow + lane;
#pragma unroll
        for (int j = 0; j < 8; ++j) { const f32x4 gg = gn[64 * j]; v2u w; w.x = pk2(x[j].x * rstd2 * gg.x, x[j].y * rstd2 * gg.y); w.y = pk2(x[j].z * rstd2 * gg.z, x[j].w * rstd2 * gg.w); o8[64 * j] = w; }
    }
}
__device__ __forceinline__ void qk_prep_rows(Frame& F, bf16* __restrict__ proj, const float* __restrict__ qg, const float* __restrict__ kg, const float* __restrict__ rope) {
    int ln = F.lane; asm volatile("" : "+v"(ln));
    const int gw = F.vcu * NWAVES + F.wave, NGW = F.G * NWAVES; const int sub = ln >> 5, i = ln & 31;
    const int NROW = M * 10;
    for (int idx = 2 * gw + sub; idx < NROW; idx += 2 * NGW) {
        const int tok = idx / 10, hh = idx - tok * 10;
        const int col0 = hh < 8 ? C_GQ + hh * HD : C_GK + (hh - 8) * HD; const float* g = hh < 8 ? qg : kg;
        GAS v2u* p = (GAS v2u*)(proj + (size_t)tok * INC + col0) + i;
        const v2u w = *p; float x[4] = {bflo(w.x), bfhi(w.x), bflo(w.y), bfhi(w.y)};
        const float ss = half_sum((x[0] * x[0] + x[1] * x[1]) + (x[2] * x[2] + x[3] * x[3]));
        const float rstd = 1.0f / sqrtf(ss * (1.f / HD) + RMS_EPS);
        const f32x4 gg = *((const GAS f32x4*)g + i);
        x[0] *= rstd * gg.x; x[1] *= rstd * gg.y; x[2] *= rstd * gg.z; x[3] *= rstd * gg.w;
        const int t = tok & (SEQ - 1); const int pos = (i & 16) ? 128 + (t & (GRIDW - 1)) : (t >> 6);
        const GAS f32x4* cs = (const GAS f32x4*)(rope + ((size_t)pos * 32 + 4 * (i & 7)) * 2);
        const f32x4 cs01 = cs[0], cs23 = cs[1];
        const float c[4] = {cs01.x, cs01.z, cs23.x, cs23.z}, s[4] = {cs01.y, cs01.w, cs23.y, cs23.w};
        float y[4];
#pragma unroll
        for (int e = 0; e < 4; ++e) { const float px = __shfl_xor(x[e], 8);
            y[e] = (i & 8) ? (px * s[e] + x[e] * c[e]) : (x[e] * c[e] - px * s[e]); }
        v2u o; o.x = pk2(y[0], y[1]); o.y = pk2(y[2], y[3]); *p = o;
    }
}
__device__ __forceinline__ void conv_rows(Frame& F, const bf16* __restrict__ proj, const float* __restrict__ cw, const float* __restrict__ cb, bf16* __restrict__ acv) {
    int ln = F.lane; asm volatile("" : "+v"(ln));
    const int gw = F.vcu * NWAVES + F.wave, NGW = F.G * NWAVES; const int c0 = ln * 16;
    float w0[16], w1[16], w2[16], bb[16];
#pragma unroll
    for (int e = 0; e < 16; ++e) { w0[e] = cw[c0 + e]; w1[e] = cw[1024 + c0 + e]; w2[e] = cw[2048 + c0 + e]; bb[e] = cb[c0 + e]; }
#define CONV_U(dst, mrow) do { const v4u* ph_ = (const v4u*)(proj + (size_t)(mrow) * INC + C_CH + c0); const v4u* pc_ = (const v4u*)(proj + (size_t)(mrow) * INC + C_CC + c0); \
        const v4u h0_ = ph_[0], h1_ = ph_[1], g0_ = pc_[0], g1_ = pc_[1]; \
        dst[0] = bflo(h0_.x) * bflo(g0_.x); dst[1] = bfhi(h0_.x) * bfhi(g0_.x); dst[2] = bflo(h0_.y) * bflo(g0_.y); dst[3] = bfhi(h0_.y) * bfhi(g0_.y); \
        dst[4] = bflo(h0_.z) * bflo(g0_.z); dst[5] = bfhi(h0_.z) * bfhi(g0_.z); dst[6] = bflo(h0_.w) * bflo(g0_.w); dst[7] = bfhi(h0_.w) * bfhi(g0_.w); \
        dst[8] = bflo(h1_.x) * bflo(g1_.x); dst[9] = bfhi(h1_.x) * bfhi(g1_.x); dst[10] = bflo(h1_.y) * bflo(g1_.y); dst[11] = bfhi(h1_.y) * bfhi(g1_.y); \
        dst[12] = bflo(h1_.z) * bflo(g1_.z); dst[13] = bfhi(h1_.z) * bfhi(g1_.z); dst[14] = bflo(h1_.w) * bflo(g1_.w); dst[15] = bfhi(h1_.w) * bfhi(g1_.w); } while (0)
    for (int m0 = gw * 8; m0 < M; m0 += NGW * 8) {
        float up[16], uc[16], un[16];
        if ((m0 & (SEQ - 1)) == 0) {
#pragma unroll
            for (int e = 0; e < 16; ++e) up[e] = 0.f;
        } else CONV_U(up, m0 - 1);
        CONV_U(uc, m0);
        for (int r = 0; r < 8; ++r) { const int m = m0 + r;
            if ((m & (SEQ - 1)) == SEQ - 1) {
#pragma unroll
                for (int e = 0; e < 16; ++e) un[e] = 0.f;
            } else CONV_U(un, m + 1);
            const v4u* pb = (const v4u*)(proj + (size_t)m * INC + C_CB + c0); const v4u b0 = pb[0], b1 = pb[1];
            const float bg[16] = {bflo(b0.x), bfhi(b0.x), bflo(b0.y), bfhi(b0.y), bflo(b0.z), bfhi(b0.z), bflo(b0.w), bfhi(b0.w), bflo(b1.x), bfhi(b1.x), bflo(b1.y), bfhi(b1.y), bflo(b1.z), bfhi(b1.z), bflo(b1.w), bfhi(b1.w)};
            float y[16];
#pragma unroll
            for (int e = 0; e < 16; ++e) y[e] = bg[e] * (bb[e] + w0[e] * up[e] + w1[e] * uc[e] + w2[e] * un[e]);
            v4u o0, o1; o0.x = pk2(y[0], y[1]); o0.y = pk2(y[2], y[3]); o0.z = pk2(y[4], y[5]); o0.w = pk2(y[6], y[7]); o1.x = pk2(y[8], y[9]); o1.y = pk2(y[10], y[11]); o1.z = pk2(y[12], y[13]); o1.w = pk2(y[14], y[15]);
            v4u* po = (v4u*)(acv + (size_t)m * 1024 + c0); po[0] = o0; po[1] = o1;
#pragma unroll
            for (int e = 0; e < 16; ++e) { up[e] = uc[e]; uc[e] = un[e]; }
        }
    }
#undef CONV_U
}

#ifndef GQA_SDEPTH
#define GQA_SDEPTH 1
#endif
struct Args { const float* in[18]; float* out; unsigned char* ws; };
typedef const __attribute__((address_space(4))) Args* KArgP;
__device__ __forceinline__ KArgP kargs() { KArgP p = (KArgP)__builtin_amdgcn_kernarg_segment_ptr(); asm volatile("" : "+s"(p)); return p; }
#define AIN(k) (kargs()->in[k])
__global__ void __launch_bounds__(NWAVES * 64, 2) mega_fwd(Args args) {
    extern __shared__ __attribute__((aligned(16))) unsigned char lds[];
    Frame F;
    F.lds = (LAS unsigned char*)lds;
    F.MISC = (volatile LAS unsigned*)(F.lds + MISC_OFF);
    F.tid = threadIdx.x; F.lane = F.tid & 63; F.wave = __builtin_amdgcn_readfirstlane(F.tid >> 6);
    F.G = gridDim.x; { const int bx = blockIdx.x; F.vcu = (F.G % 8 == 0) ? (bx % 8) * (F.G / 8) + bx / 8 : bx; }
    F.ws = args.ws; F.ctl = (gu32*)(args.ws + WS_CTL);
#define ws (kargs()->ws)
#define x_in AIN(0)
#define out (kargs()->out)
#define Hb ((bf16*)(ws + WS_H))
#define PROJ ((bf16*)(ws + WS_PROJ))
#define ACT ((bf16*)(ws + WS_ACT))
#define ANA ((bf16*)(ws + WS_ANA))
#define AGQ ((bf16*)(ws + WS_AGQ))
#define ACV ((bf16*)(ws + WS_ACV))
#define MRG ((bf16*)(ws + WS_MRG))
#define Tb ((bf16*)(ws + WS_T))
#define rope ((float*)(ws + WS_ROPE))
    for (int u = F.tid; u < (LDS_BYTES - LDSCTL_OFF) / 4; u += NWAVES * 64) ((LAS unsigned*)(F.lds + LDSCTL_OFF))[u] = 0u;
    __syncthreads();
    XcdBarrier bar = xcd_barrier_post((unsigned*)(F.ctl + CW_BAR), F.MISC + 8);
#define GRID_BAR() xcd_barrier(bar)
    const int gw = F.vcu * NWAVES + F.wave, NGW = F.G * NWAVES;

    {
        LAS float* scr = (LAS float*)(F.lds + RING_OFF + F.wave * 16384);
        constexpr int I_IN = (DM / 64) * (INC / 32), I_BR = (1024 / 64) * (DM / 32), I_OUT = (DM / 64) * (DM / 32), I_G = (DM / 64) * (FF / 32), I_D = (FF / 64) * (DM / 32);
        constexpr int I_LAYER = I_IN + 3 * I_BR + I_OUT + 2 * I_G + I_D;
#ifndef NO_TRANS
        for (int it = gw; it < DEPTH * I_LAYER; it += NGW) {
            const int l = it / I_LAYER; int r = it - l * I_LAYER;
            const float* W; bf16* WT; int K, N, mode = 0;
            if (r < I_IN) { W = AIN(1) + (size_t)l * DM * INC; WT = (bf16*)(ws + WS_WIN + l * SZ_WIN); K = DM; N = INC; }
            else if ((r -= I_IN) < 3 * I_BR) { const int br = r / I_BR; r -= br * I_BR; W = AIN(7 + br) + (size_t)l * 1024 * DM; WT = (bf16*)(ws + WS_WBR + (size_t)(l * 3 + br) * SZ_WBR); K = 1024; N = DM; }
            else if ((r -= 3 * I_BR) < I_OUT) { W = AIN(10) + (size_t)l * DM * DM; WT = (bf16*)(ws + WS_WOUT + l * SZ_WOUT); K = DM; N = DM; }
            else if ((r -= I_OUT) < 2 * I_G) { const int up = r / I_G; r -= up * I_G; W = AIN(15 + up) + (size_t)l * DM * FF; WT = (bf16*)(ws + WS_WGU + l * SZ_WGU); K = DM; N = FF; mode = 1 + up; }
            else { r -= 2 * I_G; W = AIN(17) + (size_t)l * FF * DM; WT = (bf16*)(ws + WS_WDN + l * SZ_WDN); K = FF; N = DM; }
            const int nblk = N / 32, kb = r / nblk, nb = r - kb * nblk, n0 = 32 * nb;
            const int drow = mode == 0 ? n0 : ((n0 >> 7) * 256 + (mode - 1) * 128 + (n0 & 127));
            transpose_item(W, K, N, WT, scr, 64 * kb, n0, drow, F.lane);
        }
#endif

#ifndef NO_ROPE
        for (int e = F.vcu * NWAVES * 64 + F.tid; e < 192 * 32; e += F.G * NWAVES * 64) {
            const int pos = e >> 5, i = e & 31; const int p = pos < 128 ? pos : pos - 128;
            const float inv = 1.0f / powf(10000.0f, (float)i * (1.0f / 32.0f));
            const float ang = (float)p * inv;
            rope[2 * e] = cosf(ang); rope[2 * e + 1] = sinf(ang);
        }
#endif

        { int ln = F.lane; asm volatile("" : "+v"(ln)); for (int m = gw; m < M; m += NGW) pre_row(x_in + (size_t)m * DM, AIN(11), Hb + (size_t)m * DM, ln); }
    }
    GRID_BAR();

    for (int l = 0; l < DEPTH; ++l) {
        {
            pg8::Gemm g{Hb, (const bf16*)(ws + WS_WIN + l * SZ_WIN), M, INC, DM}; pg8::StaticOrder S; S.init(M, INC, F.G, (int)blockIdx.x);
            pg8::EpiIn E{PROJ, INC, C_GNA / 256};
#ifndef NO_P1
            pg8::gemm_phase<pg8::EpiIn, pg8::StaticOrder, true, true>(F.lds + RING_OFF, g, S, E);
#endif

        }
        GRID_BAR();
#ifndef NO_QKPREP
        qk_prep_rows(F, PROJ, AIN(3) + l * HD, AIN(4) + l * HD, rope);
#endif
#ifndef NO_CONV
        conv_rows(F, PROJ, AIN(5) + (size_t)l * 3 * 1024, AIN(6) + (size_t)l * 1024, ACV);
#endif
        GRID_BAR();
        {
#ifndef NO_GQA
            for (int i = 0;; ++i) { const int unit = i * F.G + F.vcu; if (unit >= 512) break;
                const int b = unit >> 8, h = (unit >> 5) & 7, qb = unit & 31;
                const size_t tok0 = (size_t)b * SEQ + (size_t)qb * 256;
                att::attn_unit<false, GQA_SDEPTH, INC, INC, 1024>(PROJ + tok0 * INC + C_GQ + h * HD, PROJ + (size_t)b * SEQ * INC + C_GK + (h >> 2) * HD, PROJ + (size_t)b * SEQ * INC + C_GV + (h >> 2) * HD,
                                                      AGQ + tok0 * 1024 + h * HD, SEQ / 64, 0, 0, nullptr, (LAS char*)(F.lds + RING_OFF)); }
#endif
#ifndef NO_NA
            for (int i = 0;; ++i) { const int unit = i * F.G + F.vcu; if (unit >= 512) break;
                const int b = unit >> 8, h = (unit >> 5) & 7, rg = unit & 31;
                const size_t tok0 = (size_t)b * SEQ + (size_t)rg * 256; const int r0 = rg * 4, krow0 = min(max(r0 - 4, 0), 120);
                att::attn_unit<true, 1, INC, INC, 1024>(PROJ + tok0 * INC + C_NAQ + h * HD, PROJ + (size_t)b * SEQ * INC + C_NAK + h * HD, PROJ + (size_t)b * SEQ * INC + C_NAV + h * HD,
                                                     ANA + tok0 * 1024 + h * HD, 12, krow0, r0, AIN(2) + (size_t)(l * 8 + h) * 15 * 31, (LAS char*)(F.lds + RING_OFF)); }
#endif
        }
        GRID_BAR();
        {
            pg8::StaticOrder S; S.init(M, DM, F.G, (int)blockIdx.x);
#ifndef NO_P4A
            { pg8::Gemm g{ANA, (const bf16*)(ws + WS_WBR + (size_t)(l * 3 + 0) * SZ_WBR), M, DM, 1024}; pg8::EpiBranch E{MRG, DM, PROJ + C_GNA, INC, 1};
              pg8::gemm_phase<pg8::EpiBranch, pg8::StaticOrder, true, true>(F.lds + RING_OFF, g, S, E); }
#endif

#ifndef NO_P4B
            { pg8::Gemm g{AGQ, (const bf16*)(ws + WS_WBR + (size_t)(l * 3 + 1) * SZ_WBR), M, DM, 1024}; pg8::EpiBranch E{MRG, DM, PROJ + C_GGQ, INC, 0};
              pg8::gemm_phase<pg8::EpiBranch, pg8::StaticOrder, true, true>(F.lds + RING_OFF, g, S, E); }
#endif

#ifndef NO_P4C
            { pg8::Gemm g{ACV, (const bf16*)(ws + WS_WBR + (size_t)(l * 3 + 2) * SZ_WBR), M, DM, 1024}; pg8::EpiBranch E{MRG, DM, PROJ + C_GCV, INC, 0};
              pg8::gemm_phase<pg8::EpiBranch, pg8::StaticOrder, true, true>(F.lds + RING_OFF, g, S, E); }
#endif

        }
        GRID_BAR();
        {
            pg8::Gemm g{MRG, (const bf16*)(ws + WS_WOUT + l * SZ_WOUT), M, DM, DM}; pg8::StaticOrder S; S.init(M, DM, F.G, (int)blockIdx.x);
            pg8::EpiPlain E{Tb, DM};
#ifndef NO_P5
            pg8::gemm_phase<pg8::EpiPlain, pg8::StaticOrder, true, true>(F.lds + RING_OFF, g, S, E);
#endif

        }
        GRID_BAR();
        {
            const float* xsrc = l == 0 ? x_in : out;
            int ln = F.lane; asm volatile("" : "+v"(ln));
            for (int m = gw; m < M; m += NGW) post_row(Tb + (size_t)m * DM, xsrc + (size_t)m * DM, out + (size_t)m * DM, AIN(12) + l * DM, AIN(13) + l * DM, Hb + (size_t)m * DM, ln);
        }
        GRID_BAR();
        {
            pg8::Gemm g{Hb, (const bf16*)(ws + WS_WGU + l * SZ_WGU), M, NGU, DM}; pg8::StaticOrder S; S.init(M, NGU, F.G, (int)blockIdx.x);
            pg8::EpiGU E{ACT, FF};
#ifndef NO_P7
            pg8::gemm_phase<pg8::EpiGU, pg8::StaticOrder, true, true>(F.lds + RING_OFF, g, S, E);
#endif

        }
        GRID_BAR();
        {
            pg8::Gemm g{ACT, (const bf16*)(ws + WS_WDN + l * SZ_WDN), M, DM, FF}; pg8::StaticOrder S; S.init(M, DM, F.G, (int)blockIdx.x);
            pg8::EpiPlain E{Tb, DM};
#ifndef NO_P8
            pg8::gemm_phase<pg8::EpiPlain, pg8::StaticOrder, true, true>(F.lds + RING_OFF, g, S, E);
#endif

        }
        GRID_BAR();
        {
            const float* gnext = l + 1 < DEPTH ? AIN(11) + (l + 1) * DM : nullptr;
            int ln = F.lane; asm volatile("" : "+v"(ln));
            for (int m = gw; m < M; m += NGW) post_row(Tb + (size_t)m * DM, out + (size_t)m * DM, out + (size_t)m * DM, AIN(14) + l * DM, gnext, Hb + (size_t)m * DM, ln);
        }
        if (l + 1 < DEPTH) GRID_BAR();
    }
#undef ws
#undef x_in
#undef out
#undef Hb
#undef PROJ
#undef ACT
#undef ANA
#undef AGQ
#undef ACV
#undef MRG
#undef Tb
#undef rope
}

extern "C" void kernel_launch(void* const* d_in, const int* in_sizes, int n_in, void* d_out, int out_size, void* d_ws, size_t ws_size, hipStream_t stream) {
    static int grid = 0;
    if (grid == 0) {
        if (n_in != 18 || in_sizes[0] != M * DM || out_size != M * DM || ws_size < WS_END) { fprintf(stderr, "kernel_launch: shape mismatch: n_in %d in0 %d out %d ws %zu (need >= %zu)\n", n_in, n_in > 0 ? in_sizes[0] : -1, out_size, ws_size, (size_t)WS_END); grid = -1; return; }
        int dev = 0, cus = 0, per_cu = 0;
        if (hipGetDevice(&dev) != hipSuccess || hipDeviceGetAttribute(&cus, hipDeviceAttributeMultiprocessorCount, dev) != hipSuccess) { fprintf(stderr, "kernel_launch: device query failed\n"); grid = -1; return; }
        if (hipFuncSetAttribute((const void*)mega_fwd, hipFuncAttributeMaxDynamicSharedMemorySize, LDS_BYTES) != hipSuccess) { fprintf(stderr, "kernel_launch: hipFuncSetAttribute failed\n"); grid = -1; return; }
        if (hipOccupancyMaxActiveBlocksPerMultiprocessor(&per_cu, (const void*)mega_fwd, NWAVES * 64, LDS_BYTES) != hipSuccess || per_cu < 1) { fprintf(stderr, "kernel_launch: occupancy query reports %d workgroups per CU\n", per_cu); }
        (void)hipGetLastError();
        grid = cus;
    }
    if (grid < 0) return;
    if (hipMemsetAsync((char*)d_ws + WS_CTL, 0, CTL_ZERO_BYTES, stream) != hipSuccess) { fprintf(stderr, "kernel_launch: memset failed\n"); return; }
    Args a{};
    for (int i = 0; i < 18; ++i) a.in[i] = (const float*)d_in[i];
    a.out = (float*)d_out; a.ws = (unsigned char*)d_ws;
    hipLaunchKernelGGL(mega_fwd, dim3(grid), dim3(NWAVES * 64), LDS_BYTES, stream, a);
    const hipError_t le = hipPeekAtLastError();
    if (le != hipSuccess) fprintf(stderr, "kernel_launch: launch failed: %s\n", hipGetErrorName(le));
}
```

```cpp
#include <hip/hip_runtime.h>
#include <hip/hip_bf16.h>
#include <cstdio>
#include <cstdint>
#include <cmath>
__device__ __forceinline__ int lane_id() { int r; asm volatile("v_mbcnt_lo_u32_b32 %0, -1, 0\n\tv_mbcnt_hi_u32_b32 %0, -1, %0" : "=v"(r)); return r; }
__device__ __forceinline__ float shfl_xor_l(float v, int o, int lane) { return __builtin_bit_cast(float, __builtin_amdgcn_ds_bpermute((lane ^ o) << 2, __builtin_bit_cast(int, v))); }
namespace pg8 {
#define PG8_LAS __attribute__((address_space(3)))
typedef unsigned short bf16_t;
typedef short bf16x8 __attribute__((ext_vector_type(8)));
typedef float f32x4 __attribute__((ext_vector_type(4)));
typedef int i32x4 __attribute__((ext_vector_type(4)));
typedef int v8i_t __attribute__((ext_vector_type(8)));
typedef unsigned u32x4 __attribute__((ext_vector_type(4)));
constexpr int BM = 256, BK = 64, HALF = 128, HTB = HALF * BK * 2  , STAGE_BYTES = 8 * HTB, NXCD = 8, WGM = 8;

__host__ __device__ __forceinline__ int lds_byte(int r, int c) { const int st = (r >> 4) * 2 + (c >> 5), rr = r & 15, cc = c & 31, ob = rr * 64 + cc * 2; return st * 1024 + (ob ^ (((ob >> 9) & 1) << 5)); }
__host__ __device__ __forceinline__ void stage_rc(int b, int& R, int& C) { const int st = b / 1024, sb = b % 1024, swz = sb ^ (((sb >> 9) & 1) << 5); R = (st >> 1) * 16 + swz / 64; C = (st & 1) * 32 + (swz % 64) / 2; }
__host__ __device__ __forceinline__ int perm32(int rho) { const int n = rho >> 4, i = rho & 15; return 8 * (i >> 2) + 4 * n + (i & 3); }

struct Unit { int pm, pn; };
struct Gemm { const bf16_t* A; const bf16_t* Bt; int M, N, K; };

struct StaticOrder {
    int nM, nN, nwg, G, c;
    __host__ __device__ void init(int M, int N, int G_, int c_) { nM = M / BM; nN = N / BM; nwg = nM * nN; G = G_; c = c_; }
    __host__ __device__ bool next(int i, Unit& u) const {
        const long L = (long)i * G + c; if (L >= nwg) return false;
        int wgid = (int)L; { const int q = nwg / NXCD, r = nwg % NXCD, xcd = wgid % NXCD, off = wgid / NXCD; wgid = (xcd < r ? xcd * (q + 1) : r * (q + 1) + (xcd - r) * q) + off; }
        const int nig = WGM * nN, gid = wgid / nig, fm = gid * WGM, gsz = (nM - fm) < WGM ? (nM - fm) : WGM;
        u.pm = fm + ((wgid % nig) % gsz); u.pn = (wgid % nig) / gsz; return true;
    }
    __device__ __forceinline__ void a_ready(const Unit&) const {}
    __device__ __forceinline__ void done(const Unit&) const {}
};

__device__ __forceinline__ unsigned cvt_pk_bf16(float lo, float hi) { unsigned r; asm volatile("v_cvt_pk_bf16_f32 %0, %1, %2" : "=v"(r) : "v"(lo), "v"(hi)); return r; }
typedef float f32x2 __attribute__((ext_vector_type(2)));
__device__ __forceinline__ float sigm(float v) { return __builtin_amdgcn_rcpf(1.0f + __builtin_amdgcn_exp2f(-1.4426950408889634f * v)); }
__device__ __forceinline__ float bf_lo(unsigned w) { return __uint_as_float(w << 16); }
__device__ __forceinline__ float bf_hi(unsigned w) { return __uint_as_float(w & 0xffff0000u); }
__device__ __forceinline__ float row_rstd(const float* __restrict__ ssx, int row, float inv_n, float eps) {
    const f32x4 a = *(const f32x4*)(ssx + (size_t)row * 8), b = *(const f32x4*)(ssx + (size_t)row * 8 + 4);
    return __builtin_amdgcn_rsqf((((a[0] + a[1]) + (a[2] + a[3])) + ((b[0] + b[1]) + (b[2] + b[3]))) * inv_n + eps);
}
struct EpiIn {
    static constexpr bool PERM = true, AFTER_DRAIN = false, MID = false, COLSCALE = false;
    bf16_t* O; int ldc; int sig_pn; const PG8_LAS float* rt; int rbase;
    int k_pn, v_pn; bf16_t* kc; bf16_t* vc; const float* kg; const float* ropet; PG8_LAS float* xt; int seq_shift; unsigned char* g8; int g8_pn0; unsigned char* kc8; unsigned char* kn8; int kn_pn0, kn_pn1; unsigned char* vt8;
    __device__ __forceinline__ void operator()(const f32x4 (&acc)[2][2][4][2], const Unit& u, int wr, int wc, int fr, int fq) const {
        asm volatile("" : "+v"(fr), "+v"(fq));
        const int row0 = u.pm * BM + wr * 64 + fr, col0 = u.pn * BM + wc * 32 + 8 * fq; const bool sg = u.pn >= sig_pn;
        float rs[2][4];
#pragma unroll
        for (int ai = 0; ai < 2; ++ai)
#pragma unroll
            for (int m = 0; m < 4; ++m) rs[ai][m] = rt[(row0 + ai * HALF + m * 16 - rbase) & 2047];
        if (u.pn == k_pn) {
#pragma unroll
            for (int ai = 0; ai < 2; ++ai)
#pragma unroll
                for (int m = 0; m < 4; ++m)
#pragma unroll
                    for (int bj = 0; bj < 2; ++bj) { const f32x4 v0 = acc[ai][bj][m][0] * rs[ai][m], v1 = acc[ai][bj][m][1] * rs[ai][m];
                        float s = ((v0[0] * v0[0] + v0[1] * v0[1]) + (v0[2] * v0[2] + v0[3] * v0[3])) + ((v1[0] * v1[0] + v1[1] * v1[1]) + (v1[2] * v1[2] + v1[3] * v1[3]));
                        s += shfl_xor_l(s, 16, fq * 16 + fr); s += shfl_xor_l(s, 32, fq * 16 + fr);
                        if (fq == 0) xt[(bj * BM + ai * HALF + wr * 64 + m * 16 + fr) * 4 + wc] = s; }
            asm volatile("s_waitcnt lgkmcnt(0)" ::: "memory"); __builtin_amdgcn_s_barrier(); asm volatile("" ::: "memory");
            const int half = wc >> 1, i0 = 16 * (wc & 1) + 4 * fq;
            const f32x4 gA = *(const f32x4*)(kg + 64 * half + i0), gB = *(const f32x4*)(kg + 64 * half + 32 + i0);
#pragma unroll
            for (int ai = 0; ai < 2; ++ai)
#pragma unroll
                for (int m = 0; m < 4; ++m) { const int r = ai * HALF + wr * 64 + m * 16 + fr, tokg = u.pm * BM + r, t = tokg & ((1 << seq_shift) - 1), b = tokg >> seq_shift;
                    const int pos = half ? 128 + (t & 63) : (t >> 6);
                    const f32x4 cs0 = *(const f32x4*)(ropet + ((size_t)pos * 32 + i0) * 2), cs1 = *(const f32x4*)(ropet + ((size_t)pos * 32 + i0) * 2 + 4);
#pragma unroll
                    for (int bj = 0; bj < 2; ++bj) { const f32x4 pp = *(const PG8_LAS f32x4*)(xt + (bj * BM + r) * 4);
                        const float rk = __builtin_amdgcn_rsqf(((pp[0] + pp[1]) + (pp[2] + pp[3])) * (1.0f / 128.0f) + 1e-6f) * rs[ai][m];
                        const f32x4 a0 = acc[ai][bj][m][0], a1 = acc[ai][bj][m][1];
                        const float x0 = a0[0] * rk * gA[0], y0 = a0[1] * rk * gB[0], x1 = a0[2] * rk * gA[1], y1 = a0[3] * rk * gB[1];
                        const float x2 = a1[0] * rk * gA[2], y2 = a1[1] * rk * gB[2], x3 = a1[2] * rk * gA[3], y3 = a1[3] * rk * gB[3];
                        const float f0 = x0 * cs0[0] - y0 * cs0[1], f1 = x0 * cs0[1] + y0 * cs0[0], f2 = x1 * cs0[2] - y1 * cs0[3], f3 = x1 * cs0[3] + y1 * cs0[2];
                        const float f4 = x2 * cs1[0] - y2 * cs1[1], f5 = x2 * cs1[1] + y2 * cs1[0], f6 = x3 * cs1[2] - y3 * cs1[3], f7 = x3 * cs1[3] + y3 * cs1[2];
                        u32x4 w; w.x = cvt_pk_bf16(f0, f1); w.y = cvt_pk_bf16(f2, f3); w.z = cvt_pk_bf16(f4, f5); w.w = cvt_pk_bf16(f6, f7);
                        *(u32x4*)(kc + ((size_t)((b * 2 + bj) << seq_shift) + t) * 128 + wc * 32 + 8 * fq) = w;
                        { int w0 = 0, w1 = 0;
                          w0 = __builtin_amdgcn_cvt_pk_fp8_f32(f0, f1, w0, false); w0 = __builtin_amdgcn_cvt_pk_fp8_f32(f2, f3, w0, true); w1 = __builtin_amdgcn_cvt_pk_fp8_f32(f4, f5, w1, false); w1 = __builtin_amdgcn_cvt_pk_fp8_f32(f6, f7, w1, true);
                          typedef int i32x2v __attribute__((ext_vector_type(2)));
                          *(i32x2v*)(kc8 + ((size_t)((b * 2 + bj) << seq_shift) + t) * 128 + wc * 32 + 8 * fq) = (i32x2v){w0, w1}; } } }
            return;
        }
        if (u.pn == v_pn) {
#pragma unroll
            for (int ai = 0; ai < 2; ++ai)
#pragma unroll
                for (int m = 0; m < 4; ++m) { const int tokg = row0 + ai * HALF + m * 16, t = tokg & ((1 << seq_shift) - 1), b = tokg >> seq_shift;
#pragma unroll
                    for (int bj = 0; bj < 2; ++bj) { const f32x4 v0 = acc[ai][bj][m][0] * rs[ai][m], v1 = acc[ai][bj][m][1] * rs[ai][m];
                        u32x4 w; w.x = cvt_pk_bf16(v0[0], v0[1]); w.y = cvt_pk_bf16(v0[2], v0[3]); w.z = cvt_pk_bf16(v1[0], v1[1]); w.w = cvt_pk_bf16(v1[2], v1[3]);
                        *(u32x4*)(vc + ((size_t)((b * 2 + bj) << seq_shift) + t) * 128 + wc * 32 + 8 * fq) = w;
                        if (vt8) {
                            int w0 = 0, w1 = 0; w0 = __builtin_amdgcn_cvt_pk_fp8_f32(v0[0], v0[1], w0, false); w0 = __builtin_amdgcn_cvt_pk_fp8_f32(v0[2], v0[3], w0, true); w1 = __builtin_amdgcn_cvt_pk_fp8_f32(v1[0], v1[1], w1, false); w1 = __builtin_amdgcn_cvt_pk_fp8_f32(v1[2], v1[3], w1, true);
                            unsigned char* vp = vt8 + (((size_t)(b * 2 + bj) * 128 + wc * 32 + 8 * fq) << seq_shift) + t;
#pragma unroll
                            for (int q_ = 0; q_ < 4; ++q_) { vp[(size_t)q_ << seq_shift] = (unsigned char)((w0 >> (8 * q_)) & 0xff); vp[(size_t)(4 + q_) << seq_shift] = (unsigned char)((w1 >> (8 * q_)) & 0xff); } } } }
            return;
        }
        const bool k8_ = u.pn >= kn_pn0 && u.pn < kn_pn1;
        const int kpitch = 256 * (kn_pn1 - kn_pn0), kcol = 256 * (u.pn - kn_pn0) + wc * 32 + 8 * fq;
#pragma unroll
        for (int ai = 0; ai < 2; ++ai)
#pragma unroll
            for (int m = 0; m < 4; ++m) { bf16_t* rowp = O + (size_t)(row0 + ai * HALF + m * 16) * ldc + col0;
#pragma unroll
                for (int bj = 0; bj < 2; ++bj) { const f32x4 v0 = acc[ai][bj][m][0] * rs[ai][m], v1 = acc[ai][bj][m][1] * rs[ai][m];
                    u32x4 w; w.x = cvt_pk_bf16(v0[0], v0[1]); w.y = cvt_pk_bf16(v0[2], v0[3]); w.z = cvt_pk_bf16(v1[0], v1[1]); w.w = cvt_pk_bf16(v1[2], v1[3]);
                    *(u32x4*)(rowp + bj * HALF) = w;
                    if (k8_) { int w0 = 0, w1 = 0; typedef int i32x2v __attribute__((ext_vector_type(2)));
                        w0 = __builtin_amdgcn_cvt_pk_fp8_f32(v0[0], v0[1], w0, false); w0 = __builtin_amdgcn_cvt_pk_fp8_f32(v0[2], v0[3], w0, true); w1 = __builtin_amdgcn_cvt_pk_fp8_f32(v1[0], v1[1], w1, false); w1 = __builtin_amdgcn_cvt_pk_fp8_f32(v1[2], v1[3], w1, true);
                        *(i32x2v*)(kn8 + (size_t)(row0 + ai * HALF + m * 16) * kpitch + kcol + bj * HALF) = (i32x2v){w0, w1}; } } }
    }
};
struct EpiPlain {
    static constexpr bool PERM = true, AFTER_DRAIN = false, MID = false, COLSCALE = false;
    bf16_t* O; int ldc;
    __device__ __forceinline__ void operator()(const f32x4 (&acc)[2][2][4][2], const Unit& u, int wr, int wc, int fr, int fq) const {
        asm volatile("" : "+v"(fr), "+v"(fq));
        const int row0 = u.pm * BM + wr * 64 + fr, col0 = u.pn * BM + wc * 32 + 8 * fq;
#pragma unroll
        for (int ai = 0; ai < 2; ++ai)
#pragma unroll
            for (int m = 0; m < 4; ++m) { bf16_t* rowp = O + (size_t)(row0 + ai * HALF + m * 16) * ldc + col0;
#pragma unroll
                for (int bj = 0; bj < 2; ++bj) { const f32x4 v0 = acc[ai][bj][m][0], v1 = acc[ai][bj][m][1];
                    u32x4 w; w.x = cvt_pk_bf16(v0[0], v0[1]); w.y = cvt_pk_bf16(v0[2], v0[3]); w.z = cvt_pk_bf16(v1[0], v1[1]); w.w = cvt_pk_bf16(v1[2], v1[3]);
                    *(u32x4*)(rowp + bj * HALF) = w; } }
    }
};
template <int T1_, int T2_, bool CS>
struct EpiBranchK {
    static constexpr bool PERM = true, AFTER_DRAIN = false, MID = true, COLSCALE = false; static constexpr int MID_T1 = T1_, MID_T2 = T2_;
    bf16_t* O; int ldc; const unsigned char* G8; size_t gstride;
    const float* csc;
    __device__ __forceinline__ static float ub(unsigned w, int k) { return (float)((w >> (8 * k)) & 0xffu); }
    __device__ __forceinline__ void mid(f32x4 (&acc)[2][2][4][2], const Unit& u, int t, int wr, int wc, int fr, int fq) const {
        asm volatile("" : "+v"(fr), "+v"(fq));
        typedef const __attribute__((address_space(1))) char* gcp; typedef unsigned u32x2v __attribute__((ext_vector_type(2))); typedef const __attribute__((address_space(1))) u32x2v* gv2;
        const int row0 = u.pm * BM + wr * 64 + fr, col0 = u.pn * BM + wc * 32 + 8 * fq;
        gcp Ga = (gcp)(G8 + (t == MID_T1 ? 0 : 1) * gstride), Gb = (gcp)(G8 + (t == MID_T1 ? 1 : 2) * gstride);
        const unsigned off0 = (unsigned)row0 * 2048u + (unsigned)col0;
        u32x2v a[2][4][2], b[2][4][2];
#pragma unroll
        for (int ai = 0; ai < 2; ++ai)
#pragma unroll
            for (int m = 0; m < 4; ++m)
#pragma unroll
                for (int bj = 0; bj < 2; ++bj) { const unsigned o = off0 + (unsigned)(ai * HALF + m * 16) * 2048u + bj * HALF; a[ai][m][bj] = *(gv2)(Ga + o); b[ai][m][bj] = *(gv2)(Gb + o); }
#pragma unroll
        for (int ai = 0; ai < 2; ++ai)
#pragma unroll
            for (int m = 0; m < 4; ++m)
#pragma unroll
                for (int bj = 0; bj < 2; ++bj) { const u32x2v av = a[ai][m][bj], bv = b[ai][m][bj]; f32x4 r0, r1;
#pragma unroll
                    for (int k = 0; k < 4; ++k) { r0[k] = ub(av.x, k) * __builtin_amdgcn_rcpf(ub(bv.x, k)); r1[k] = ub(av.y, k) * __builtin_amdgcn_rcpf(ub(bv.y, k)); }
                    acc[ai][bj][m][0] *= r0; acc[ai][bj][m][1] *= r1; }
    }
    __device__ __forceinline__ void operator()(const f32x4 (&acc)[2][2][4][2], const Unit& u, int wr, int wc, int fr, int fq) const {
        asm volatile("" : "+v"(fr), "+v"(fq));
        typedef unsigned u32x2v __attribute__((ext_vector_type(2)));
        const int row0 = u.pm * BM + wr * 64 + fr, col0 = u.pn * BM + wc * 32 + 8 * fq;
#pragma unroll
        for (int ai = 0; ai < 2; ++ai)
#pragma unroll
            for (int m = 0; m < 4; ++m) { const size_t row = (size_t)(row0 + ai * HALF + m * 16); bf16_t* rowp = O + row * ldc + col0; const unsigned char* gp = G8 + 2 * gstride + row * 2048 + col0;
#pragma unroll
                for (int bj = 0; bj < 2; ++bj) { f32x4 a0 = acc[ai][bj][m][0], a1 = acc[ai][bj][m][1];
                    if constexpr (CS) { a0 *= *(const f32x4*)(csc + col0 + bj * HALF); a1 *= *(const f32x4*)(csc + col0 + bj * HALF + 4); }
                    const u32x2v g = *(const u32x2v*)(gp + bj * HALF); constexpr float S = 1.0f / 255.0f;
                    u32x4 w; w.x = cvt_pk_bf16(a0[0] * (ub(g.x, 0) * S), a0[1] * (ub(g.x, 1) * S)); w.y = cvt_pk_bf16(a0[2] * (ub(g.x, 2) * S), a0[3] * (ub(g.x, 3) * S));
                    w.z = cvt_pk_bf16(a1[0] * (ub(g.y, 0) * S), a1[1] * (ub(g.y, 1) * S)); w.w = cvt_pk_bf16(a1[2] * (ub(g.y, 2) * S), a1[3] * (ub(g.y, 3) * S));
                    *(u32x4*)(rowp + bj * HALF) = w; } }
    }
};
struct EpiGU {
    static constexpr bool PERM = true, AFTER_DRAIN = false, MID = false, COLSCALE = false;
    bf16_t* O; int ldc; const PG8_LAS float* rt; int rbase;
    __device__ __forceinline__ void operator()(const f32x4 (&acc)[2][2][4][2], const Unit& u, int wr, int wc, int fr, int fq) const {
        asm volatile("" : "+v"(fr), "+v"(fq));
        const int row0 = u.pm * BM + wr * 64 + fr, col0 = u.pn * HALF + wc * 32 + 8 * fq;
        float rs[2][4];
#pragma unroll
        for (int ai = 0; ai < 2; ++ai)
#pragma unroll
            for (int m = 0; m < 4; ++m) rs[ai][m] = rt[(row0 + ai * HALF + m * 16 - rbase) & 2047];
#pragma unroll
        for (int ai = 0; ai < 2; ++ai)
#pragma unroll
            for (int m = 0; m < 4; ++m) { bf16_t* rowp = O + (size_t)(row0 + ai * HALF + m * 16) * ldc + col0;
                const f32x4 g0 = acc[ai][0][m][0] * rs[ai][m], g1 = acc[ai][0][m][1] * rs[ai][m], u0 = acc[ai][1][m][0] * rs[ai][m], u1 = acc[ai][1][m][1] * rs[ai][m];
                u32x4 w; w.x = cvt_pk_bf16(g0[0] * sigm(g0[0]) * u0[0], g0[1] * sigm(g0[1]) * u0[1]); w.y = cvt_pk_bf16(g0[2] * sigm(g0[2]) * u0[2], g0[3] * sigm(g0[3]) * u0[3]);
                w.z = cvt_pk_bf16(g1[0] * sigm(g1[0]) * u1[0], g1[1] * sigm(g1[1]) * u1[1]); w.w = cvt_pk_bf16(g1[2] * sigm(g1[2]) * u1[2], g1[3] * sigm(g1[3]) * u1[3]);
                *(u32x4*)rowp = w; }
    }
};

struct PanelSS {
    unsigned* xbuf;
    unsigned* cnt;
    unsigned* tmo;
    float inv_n, eps; unsigned code;
    __device__ __forceinline__ bool run(const f32x4 (&v)[2][2][4][2], const Unit& u, int wr, int wc, int fr, int fq, PG8_LAS unsigned char* lds, int wid, int lane) const {
        PG8_LAS float* P = (PG8_LAS float*)lds;
        PG8_LAS float* S = (PG8_LAS float*)(lds + 8192);
        PG8_LAS unsigned* flag = (PG8_LAS unsigned*)(lds + 8192 + 2048);
#pragma unroll
        for (int ai = 0; ai < 2; ++ai)
#pragma unroll
            for (int m = 0; m < 4; ++m) {
                float s = 0.f;
#pragma unroll
                for (int bj = 0; bj < 2; ++bj)
#pragma unroll
                    for (int n = 0; n < 2; ++n) { const f32x4 x = v[ai][bj][m][n]; s += (x[0] * x[0] + x[1] * x[1]) + (x[2] * x[2] + x[3] * x[3]); }
                s += shfl_xor_l(s, 16, fq * 16 + fr); s += shfl_xor_l(s, 32, fq * 16 + fr);
                if (fq == 0) P[(ai * HALF + wr * 64 + m * 16 + fr) * 4 + wc] = s;
            }
        asm volatile("s_waitcnt lgkmcnt(0)" ::: "memory"); __builtin_amdgcn_s_barrier(); asm volatile("" ::: "memory");
        const int row = wid * 32 + (lane & 31);
        if (lane < 32) {
            const float tot = (P[row * 4 + 0] + P[row * 4 + 1]) + (P[row * 4 + 2] + P[row * 4 + 3]);
            unsigned* slot = xbuf + ((size_t)(u.pm * BM + row) * 8 + u.pn);
            __hip_atomic_store(slot, __float_as_uint(tot), __ATOMIC_RELAXED, __HIP_MEMORY_SCOPE_AGENT);
        }
        asm volatile("s_waitcnt vmcnt(0)" ::: "memory");
        if (lane == 0) __hip_atomic_fetch_add(cnt + 64 * u.pm, 1u, __ATOMIC_RELAXED, __HIP_MEMORY_SCOPE_AGENT);
        if (wid == 0) {
            bool dead = false; const unsigned long long t0 = __builtin_amdgcn_s_memrealtime(); const unsigned want = 64u;
            for (;;) {
                if ((unsigned)__builtin_amdgcn_readfirstlane(__hip_atomic_load(cnt + 64 * u.pm, __ATOMIC_RELAXED, __HIP_MEMORY_SCOPE_AGENT)) >= want) break;
                if (__builtin_amdgcn_s_memrealtime() - t0 > 2000000ull) {
                    if (lane == 0) { unsigned expect = 0u; __hip_atomic_compare_exchange_strong(tmo + 1, &expect, code | (unsigned)(u.pm & 0xff), __ATOMIC_RELAXED, __ATOMIC_RELAXED, __HIP_MEMORY_SCOPE_AGENT);
                                     __hip_atomic_store(tmo, 1u, __ATOMIC_RELAXED, __HIP_MEMORY_SCOPE_AGENT); }
                    dead = true; break; }
                __builtin_amdgcn_s_sleep(2);
            }
            __builtin_amdgcn_fence(__ATOMIC_ACQUIRE, "agent");
            if (lane == 0) flag[0] = dead ? 1u : 0u;
        }
        asm volatile("s_waitcnt vmcnt(0) lgkmcnt(0)" ::: "memory"); __builtin_amdgcn_s_barrier(); asm volatile("" ::: "memory");
        const bool bad = flag[0] != 0u;
        if (lane < 32) {
            const unsigned* slot = xbuf + (size_t)(u.pm * BM + row) * 8; float tot = 0.f;
#pragma unroll
            for (int t = 0; t < 8; ++t) tot += __uint_as_float(__hip_atomic_load(slot + t, __ATOMIC_RELAXED, __HIP_MEMORY_SCOPE_AGENT));
            S[row] = __builtin_amdgcn_rsqf(tot * inv_n + eps);
        }
        asm volatile("s_waitcnt lgkmcnt(0)" ::: "memory"); __builtin_amdgcn_s_barrier(); asm volatile("" ::: "memory");
        return bad;
    }
};
struct EpiNormRes {
    static constexpr bool PERM = false, AFTER_DRAIN = true, MID = false, COLSCALE = false;
    const float* base; float* out; bf16_t* xb; int ldc; const float* gain; float* ssx; PanelSS st;
    __device__ __forceinline__ void fused(f32x4 (&acc)[2][2][4][2], const Unit& u, int wr, int wc, int fr, int fq, PG8_LAS unsigned char* lds, int wid, int lane) const {
        typedef unsigned u32x2v __attribute__((ext_vector_type(2)));
        PG8_LAS float* P = (PG8_LAS float*)lds; const PG8_LAS float* S = (const PG8_LAS float*)(lds + 8192);
        const int col0 = u.pn * BM + wc * 32 + 4 * fq;
        f32x4 gv[2][2];
#pragma unroll
        for (int bj = 0; bj < 2; ++bj)
#pragma unroll
            for (int n = 0; n < 2; ++n) gv[bj][n] = *(const f32x4*)(gain + col0 + bj * HALF + n * 16);
        f32x4 pre[4][2][2];
#pragma unroll
        for (int m = 0; m < 4; ++m) { const size_t off = (size_t)(u.pm * BM + wr * 64 + m * 16 + fr) * ldc + col0;
#pragma unroll
            for (int bj = 0; bj < 2; ++bj)
#pragma unroll
                for (int n = 0; n < 2; ++n) pre[m][bj][n] = *(const f32x4*)(base + off + bj * HALF + n * 16); }
        const bool bad = st.run(acc, u, wr, wc, fr, fq, lds, wid, lane);
        const float qnan = __builtin_nanf("");
#pragma unroll
        for (int ai = 0; ai < 2; ++ai)
#pragma unroll
            for (int m = 0; m < 4; ++m) { const int r = ai * HALF + wr * 64 + m * 16 + fr; const float sr = S[r]; const size_t off = (size_t)(u.pm * BM + r) * ldc + col0; float ssl = 0.f;
#pragma unroll
                for (int bj = 0; bj < 2; ++bj)
#pragma unroll
                    for (int n = 0; n < 2; ++n) { const f32x4 bs = ai == 0 ? pre[m][bj][n] : *(const f32x4*)(base + off + bj * HALF + n * 16); f32x4 o = bs + acc[ai][bj][m][n] * sr * gv[bj][n];
                        if (bad) o = (f32x4){qnan, qnan, qnan, qnan}; *(f32x4*)(out + off + bj * HALF + n * 16) = o;
                        u32x2v w; w.x = cvt_pk_bf16(o[0], o[1]); w.y = cvt_pk_bf16(o[2], o[3]); *(u32x2v*)(xb + off + bj * HALF + n * 16) = w;
                        ssl += (o[0] * o[0] + o[1] * o[1]) + (o[2] * o[2] + o[3] * o[3]); }
                ssl += shfl_xor_l(ssl, 16, fq * 16 + fr); ssl += shfl_xor_l(ssl, 32, fq * 16 + fr);
                if (fq == 0) P[r * 4 + wc] = ssl;
                if (m & 1) asm volatile("" ::: "memory"); }
        asm volatile("s_waitcnt lgkmcnt(0)" ::: "memory"); __builtin_amdgcn_s_barrier(); asm volatile("" ::: "memory");
        if (lane < 32) { const int row = wid * 32 + lane; ssx[(size_t)(u.pm * BM + row) * 8 + u.pn] = (P[row * 4 + 0] + P[row * 4 + 1]) + (P[row * 4 + 2] + P[row * 4 + 3]); }
    }
};
struct PanelOrder {
    int s, c;
    __device__ __forceinline__ bool next(int i, Unit& u) const { if (i != 0) return false; const int x = c & 7, j = c >> 3; u.pn = j & 7; u.pm = 32 * s + 4 * x + (j >> 3); return true; }
    __device__ __forceinline__ void a_ready(const Unit&) const {}
    __device__ __forceinline__ void done(const Unit&) const {}
};

struct EpiGate8 {
    static constexpr bool PERM = true, AFTER_DRAIN = false, MID = false, COLSCALE = false;
    unsigned char* g8; size_t gstride; const PG8_LAS float* rt; int rbase; const float* wsc;
    __device__ __forceinline__ void operator()(const f32x4 (&acc)[2][2][4][2], const Unit& u, int wr, int wc, int fr, int fq) const {
        asm volatile("" : "+v"(fr), "+v"(fq));
        typedef unsigned u32x2v __attribute__((ext_vector_type(2)));
        const int row0 = u.pm * BM + wr * 64 + fr, gi = u.pn >> 3, gc0 = (u.pn & 7) * BM + wc * 32 + 8 * fq, wc0 = u.pn * BM + wc * 32 + 8 * fq;
        f32x4 ws[2][2];
#pragma unroll
        for (int bj = 0; bj < 2; ++bj) { ws[bj][0] = *(const f32x4*)(wsc + wc0 + bj * HALF); ws[bj][1] = *(const f32x4*)(wsc + wc0 + bj * HALF + 4); }
        unsigned char* gb = g8 + (size_t)gi * gstride + gc0;
#pragma unroll
        for (int ai = 0; ai < 2; ++ai)
#pragma unroll
            for (int m = 0; m < 4; ++m) { const float rs = rt[(row0 + ai * HALF + m * 16 - rbase) & 2047];
#pragma unroll
                for (int bj = 0; bj < 2; ++bj) { const f32x4 v0 = acc[ai][bj][m][0] * rs * ws[bj][0], v1 = acc[ai][bj][m][1] * rs * ws[bj][1];
                    unsigned q[8];
#pragma unroll
                    for (int e2 = 0; e2 < 4; ++e2) { q[e2] = (unsigned)fminf(fmaxf(__builtin_rintf(sigm(v0[e2]) * 255.0f), 1.0f), 255.0f); q[4 + e2] = (unsigned)fminf(fmaxf(__builtin_rintf(sigm(v1[e2]) * 255.0f), 1.0f), 255.0f); }
                    u32x2v w; w.x = q[0] | (q[1] << 8) | (q[2] << 16) | (q[3] << 24); w.y = q[4] | (q[5] << 8) | (q[6] << 16) | (q[7] << 24);
                    *(u32x2v*)(gb + (size_t)(row0 + ai * HALF + m * 16) * 2048 + bj * HALF) = w; } }
    }
};
template <int NA_, int NB_>
struct GateOrder {
    int c;
    __device__ __forceinline__ bool next(int i, Unit& u) const {
        const int x = c & 7, j = c >> 3; int q;
        if (j < 16) { if (i >= NA_) return false; q = NA_ * j + i; } else { if (i >= NB_) return false; q = 16 * NA_ + NB_ * (j - 16) + i; }
        u.pm = 8 * x + (q & 7); u.pn = q >> 3; return true;
    }
    __device__ __forceinline__ void a_ready(const Unit&) const {}
    __device__ __forceinline__ void done(const Unit&) const {}
};
template <int NIN>
struct EpiInGate8 {
    static constexpr bool PERM = true, AFTER_DRAIN = false, MID = false, COLSCALE = true;
    EpiIn in; unsigned char* g8; size_t gstride; const float* wsc;
    __device__ __forceinline__ void operator()(const f32x4 (&acc)[2][2][4][2], const Unit& u, int wr, int wc, int fr, int fq) const {
        if (u.pn < NIN) { in(acc, u, wr, wc, fr, fq); return; }
        asm volatile("" : "+v"(fr), "+v"(fq));
        typedef unsigned u32x2v __attribute__((ext_vector_type(2)));
        const int pg = u.pn - NIN, row0 = u.pm * BM + wr * 64 + fr, gi = pg >> 3, gc0 = (pg & 7) * BM + wc * 32 + 8 * fq;
        unsigned char* gb = g8 + (size_t)gi * gstride + gc0;
#pragma unroll
        for (int ai = 0; ai < 2; ++ai)
#pragma unroll
            for (int m = 0; m < 4; ++m) { const float rs = in.rt[(row0 + ai * HALF + m * 16 - in.rbase) & 2047] * -1.4426950408889634f;
#pragma unroll
                for (int bj = 0; bj < 2; ++bj) { const f32x4 v0 = acc[ai][bj][m][0] * rs, v1 = acc[ai][bj][m][1] * rs;
                    u32x2v w = {0u, 0u};
#pragma unroll
                    for (int e2 = 0; e2 < 4; ++e2) {
                        const float g0 = __builtin_rintf(fmaxf(__builtin_amdgcn_rcpf(fmaf(__builtin_amdgcn_exp2f(v0[e2]), 1.0f / 255.0f, 1.0f / 255.0f)), 1.0f));
                        const float g1 = __builtin_rintf(fmaxf(__builtin_amdgcn_rcpf(fmaf(__builtin_amdgcn_exp2f(v1[e2]), 1.0f / 255.0f, 1.0f / 255.0f)), 1.0f));
                        w.x = __builtin_amdgcn_cvt_pk_u8_f32(g0, e2, w.x); w.y = __builtin_amdgcn_cvt_pk_u8_f32(g1, e2, w.y); }
                    *(u32x2v*)(gb + (size_t)(row0 + ai * HALF + m * 16) * 2048 + bj * HALF) = w; } }
    }
};

struct EpiGU8 {
    static constexpr bool PERM = true, AFTER_DRAIN = false, MID = false, COLSCALE = false;
    bf16_t* O; int ldc; const PG8_LAS float* rt; int rbase; const float* wsc;
    __device__ __forceinline__ void operator()(const f32x4 (&acc)[2][2][4][2], const Unit& u, int wr, int wc, int fr, int fq) const {
        asm volatile("" : "+v"(fr), "+v"(fq));
        const int row0 = u.pm * BM + wr * 64 + fr, col0 = u.pn * HALF + wc * 32 + 8 * fq, wc0 = u.pn * BM + wc * 32 + 8 * fq;
        const f32x4 wg0 = *(const f32x4*)(wsc + wc0), wg1 = *(const f32x4*)(wsc + wc0 + 4), wu0 = *(const f32x4*)(wsc + wc0 + HALF), wu1 = *(const f32x4*)(wsc + wc0 + HALF + 4);
#pragma unroll
        for (int ai = 0; ai < 2; ++ai)
#pragma unroll
            for (int m = 0; m < 4; ++m) { bf16_t* rowp = O + (size_t)(row0 + ai * HALF + m * 16) * ldc + col0; const float rs = rt[(row0 + ai * HALF + m * 16 - rbase) & 2047];
                const f32x4 g0 = acc[ai][0][m][0] * rs * wg0, g1 = acc[ai][0][m][1] * rs * wg1, u0 = acc[ai][1][m][0] * rs * wu0, u1 = acc[ai][1][m][1] * rs * wu1;
                u32x4 w; w.x = cvt_pk_bf16(g0[0] * sigm(g0[0]) * u0[0], g0[1] * sigm(g0[1]) * u0[1]); w.y = cvt_pk_bf16(g0[2] * sigm(g0[2]) * u0[2], g0[3] * sigm(g0[3]) * u0[3]);
                w.z = cvt_pk_bf16(g1[0] * sigm(g1[0]) * u1[0], g1[1] * sigm(g1[1]) * u1[1]); w.w = cvt_pk_bf16(g1[2] * sigm(g1[2]) * u1[2], g1[3] * sigm(g1[3]) * u1[3]);
                *(u32x4*)rowp = w; }
    }
};
template <class Epi, class Sched, bool ALIGN_EPI = false, bool SP2 = false, bool I8 = false, int MIX8 = 0>
__device__ __forceinline__ void gemm_phase(PG8_LAS unsigned char* lds, const Gemm g, const Sched& S, const Epi& E, const int wave  ) {
    int tid_ = wave * 64 + lane_id(); asm volatile("" : "+v"(tid_));
    const int tid = tid_, wid = __builtin_amdgcn_readfirstlane(tid >> 6), lane = tid & 63, wr = wid >> 2, wc = wid & 3, fr = lane & 15, fq = lane >> 4;
    const int K = g.K, nt = K / BK;
    unsigned voffA[2], voffB[2];
#pragma unroll
    for (int i = 0; i < 2; ++i) { int R, C; stage_rc(tid * 16 + i * 8192, R, C); const int Rb = Epi::PERM ? ((R & ~31) + perm32(R & 31)) : R;
        voffA[i] = (unsigned)(R * K + C) * 2u; voffB[i] = (unsigned)(Rb * K + C) * 2u; }
    const size_t kstep = (size_t)(BK * 2);
    const size_t hstep = (size_t)HALF * K * 2;
    const size_t tstep = 2 * hstep;
    const unsigned ldsw = (unsigned)wid * 1024u;
    const int aoff = lds_byte(wr * 64 + fr, fq * 8), boff = lds_byte(wc * 32 + fr, fq * 8);
#define PG8_SA(b, h) (((b) * 2 + (h)) * HTB)
#define PG8_SB(b, h) ((4 + (b) * 2 + (h)) * HTB)
#define PG8_STAGE(bufoff, gbase, voff) do { const char* gb_ = (const char*)(gbase); asm volatile("" : "+s"(gb_));     \
        _Pragma("unroll") for (int _i = 0; _i < 2; ++_i) \
        { unsigned vo_ = (voff)[_i]; asm volatile("" : "+v"(vo_)); __builtin_amdgcn_global_load_lds((const unsigned*)(gb_ + vo_), (PG8_LAS unsigned*)(lds + (bufoff) + ldsw + _i * 8192), 16, 0, 0); } } while (0)
#define PG8_LDA(dst, b, h) do { _Pragma("unroll") for (int m = 0; m < 4; ++m) _Pragma("unroll") for (int k = 0; k < 2; ++k) dst[m][k] = *(const PG8_LAS bf16x8*)(lds + PG8_SA(b, h) + aoff + m * 2048 + k * 1024); } while (0)
#define PG8_LDB(dst, b, h) do { _Pragma("unroll") for (int n = 0; n < 2; ++n) _Pragma("unroll") for (int k = 0; k < 2; ++k) dst[n][k] = *(const PG8_LAS bf16x8*)(lds + PG8_SB(b, h) + boff + n * 2048 + k * 1024); } while (0)
#define PG8_CAT8(x, y) (v8i_t){__builtin_bit_cast(i32x4, x)[0], __builtin_bit_cast(i32x4, x)[1], __builtin_bit_cast(i32x4, x)[2], __builtin_bit_cast(i32x4, x)[3], __builtin_bit_cast(i32x4, y)[0], __builtin_bit_cast(i32x4, y)[1], __builtin_bit_cast(i32x4, y)[2], __builtin_bit_cast(i32x4, y)[3]}
#define PG8_MMA8(ai, bj, At, Bt) do { __builtin_amdgcn_s_setprio(1); _Pragma("unroll") for (int m = 0; m < 4; ++m) _Pragma("unroll") for (int n = 0; n < 2; ++n) \
          acc[ai][bj][m][n] = __builtin_amdgcn_mfma_scale_f32_16x16x128_f8f6f4(PG8_CAT8(Bt[n][0], Bt[n][1]), PG8_CAT8(At[m][0], At[m][1]), acc[ai][bj][m][n], 0, 0, 0, 0x7D7D7D7D, 0, 0x7D7D7D7D  ); __builtin_amdgcn_s_setprio(0); } while (0)
#define PG8_MMA(ai, bj, At, Bt) do { __builtin_amdgcn_s_setprio(1); _Pragma("unroll") for (int m = 0; m < 4; ++m) _Pragma("unroll") for (int n = 0; n < 2; ++n) _Pragma("unroll") for (int k = 0; k < 2; ++k) \
        { if constexpr (I8) acc[ai][bj][m][n] = __builtin_bit_cast(f32x4, __builtin_amdgcn_mfma_i32_16x16x64_i8(__builtin_bit_cast(i32x4, Bt[n][k]), __builtin_bit_cast(i32x4, At[m][k]), __builtin_bit_cast(i32x4, acc[ai][bj][m][n]), 0, 0, 0)); \
          else acc[ai][bj][m][n] = __builtin_amdgcn_mfma_f32_16x16x32_bf16(Bt[n][k], At[m][k], acc[ai][bj][m][n], 0, 0, 0); } __builtin_amdgcn_s_setprio(0); } while (0)
#define PG8_WAIT_V(n) asm volatile("s_waitcnt vmcnt(" #n ")" ::: "memory")
#define PG8_WAIT_L(n) asm volatile("s_waitcnt lgkmcnt(" #n ")" ::: "memory")
#define PG8_BAR __builtin_amdgcn_s_barrier()
#define PG8_SCHED __builtin_amdgcn_sched_barrier(0)
    Unit cur, nxt; int ui = 0;
    if (!S.next(0, cur)) return;
    f32x4 acc[2][2][4][2];
#pragma unroll
    for (int a = 0; a < 2; ++a)
#pragma unroll
        for (int b = 0; b < 2; ++b)
#pragma unroll
            for (int m = 0; m < 4; ++m)
#pragma unroll
                for (int n = 0; n < 2; ++n) acc[a][b][m][n] = (f32x4){0.f, 0.f, 0.f, 0.f};
    bf16x8 At[4][2], B0[2][2], B1[2][2];
    const char* cA = (const char*)g.A + (size_t)cur.pm * tstep; const char* cB = (const char*)g.Bt + (size_t)cur.pn * tstep;
    S.a_ready(cur);
    if constexpr (SP2) {
        PG8_STAGE(PG8_SB(0, 0), cB, voffB); PG8_STAGE(PG8_SB(0, 1), cB + hstep, voffB); PG8_STAGE(PG8_SA(0, 0), cA, voffA); PG8_STAGE(PG8_SA(0, 1), cA + hstep, voffA);
        if (wr == 1) PG8_BAR;
        PG8_WAIT_V(2); PG8_BAR;
        PG8_STAGE(PG8_SB(1, 0), cB + kstep, voffB); PG8_STAGE(PG8_SA(1, 0), cA + kstep, voffA); PG8_STAGE(PG8_SB(1, 1), cB + hstep + kstep, voffB);
        PG8_WAIT_V(6); PG8_BAR;
    } else {
        PG8_STAGE(PG8_SB(0, 0), cB, voffB); PG8_STAGE(PG8_SA(0, 0), cA, voffA); PG8_STAGE(PG8_SB(0, 1), cB + hstep, voffB); PG8_STAGE(PG8_SA(0, 1), cA + hstep, voffA);
        if (wr == 1) PG8_BAR;
        PG8_WAIT_V(4); PG8_BAR;
        PG8_STAGE(PG8_SB(1, 0), cB + kstep, voffB); PG8_STAGE(PG8_SA(1, 0), cA + kstep, voffA); PG8_STAGE(PG8_SB(1, 1), cB + hstep + kstep, voffB);
        PG8_WAIT_V(6); PG8_BAR;
    }
    for (;;) {
        const bool has_next = S.next(ui + 1, nxt);
        const char* nA = has_next ? (const char*)g.A + (size_t)nxt.pm * tstep : cA; const char* nB = has_next ? (const char*)g.Bt + (size_t)nxt.pn * tstep : cB;
        if constexpr (MIX8 > 0) {
        for (int t = 0; t < MIX8; t += 2) {
            const bool last = (t == nt - 2);
            const char* a1 = cA + (size_t)(t + 1) * kstep;
            const char* a2 = last ? nA : cA + (size_t)(t + 2) * kstep; const char* b2 = last ? nB : cB + (size_t)(t + 2) * kstep;
            const char* a3 = a2 + kstep; const char* b3 = b2 + kstep;
            if (last && has_next) S.a_ready(nxt);
            if constexpr (Epi::MID) { if (t == Epi::MID_T1 || t == Epi::MID_T2) { PG8_SCHED; E.mid(acc, cur, t, wr, wc, fr, fq); PG8_SCHED; } }
            if constexpr (SP2) {
            PG8_LDB(B0, 0, 0); PG8_LDB(B1, 0, 1); PG8_SCHED; PG8_LDA(At, 0, 0); PG8_STAGE(PG8_SA(1, 1), a1 + hstep, voffA);
            PG8_WAIT_V(8); PG8_WAIT_L(0); PG8_BAR; PG8_MMA8(0, 0, At, B0); PG8_MMA8(0, 1, At, B1); PG8_BAR; PG8_SCHED;
            PG8_LDA(At, 0, 1); PG8_STAGE(PG8_SB(0, 0), b2, voffB); PG8_STAGE(PG8_SB(0, 1), b2 + hstep, voffB); PG8_STAGE(PG8_SA(0, 0), a2, voffA);
            PG8_WAIT_V(8); PG8_WAIT_L(0); PG8_BAR; PG8_MMA8(1, 0, At, B0); PG8_MMA8(1, 1, At, B1); PG8_BAR; PG8_SCHED;
            PG8_LDB(B0, 1, 0); PG8_LDB(B1, 1, 1); PG8_SCHED; PG8_LDA(At, 1, 0); PG8_STAGE(PG8_SA(0, 1), a2 + hstep, voffA);
            PG8_WAIT_V(8); PG8_WAIT_L(0); PG8_BAR; PG8_MMA8(0, 0, At, B0); PG8_MMA8(0, 1, At, B1); PG8_BAR; PG8_SCHED;
            PG8_LDA(At, 1, 1); PG8_STAGE(PG8_SB(1, 0), b3, voffB); PG8_STAGE(PG8_SB(1, 1), b3 + hstep, voffB); PG8_STAGE(PG8_SA(1, 0), a3, voffA);
            PG8_WAIT_V(8); PG8_WAIT_L(0); PG8_BAR; PG8_MMA8(1, 0, At, B0); PG8_MMA8(1, 1, At, B1); PG8_BAR; PG8_SCHED;
            } else {
            PG8_LDB(B0, 0, 0); PG8_SCHED; PG8_LDA(At, 0, 0); PG8_STAGE(PG8_SA(1, 1), a1 + hstep, voffA);
            PG8_WAIT_L(8); PG8_BAR; PG8_WAIT_L(0); PG8_MMA8(0, 0, At, B0); PG8_BAR; PG8_SCHED;
            PG8_LDB(B1, 0, 1); PG8_STAGE(PG8_SB(0, 0), b2, voffB);
            PG8_BAR; PG8_WAIT_L(0); PG8_MMA8(0, 1, At, B1); PG8_BAR;
            PG8_LDA(At, 0, 1); PG8_STAGE(PG8_SA(0, 0), a2, voffA);
            PG8_BAR; PG8_WAIT_L(0); PG8_MMA8(1, 0, At, B0); PG8_BAR; PG8_SCHED;
            PG8_STAGE(PG8_SB(0, 1), b2 + hstep, voffB);
            PG8_WAIT_V(6); PG8_BAR; PG8_MMA8(1, 1, At, B1); PG8_BAR;
            PG8_LDB(B0, 1, 0); PG8_SCHED; PG8_LDA(At, 1, 0); PG8_STAGE(PG8_SA(0, 1), a2 + hstep, voffA);
            PG8_WAIT_L(8); PG8_BAR; PG8_WAIT_L(0); PG8_MMA8(0, 0, At, B0); PG8_BAR; PG8_SCHED;
            PG8_LDB(B1, 1, 1); PG8_STAGE(PG8_SB(1, 0), b3, voffB);
            PG8_BAR; PG8_WAIT_L(0); PG8_MMA8(0, 1, At, B1); PG8_BAR;
            PG8_LDA(At, 1, 1); PG8_STAGE(PG8_SA(1, 0), a3, voffA);
            PG8_BAR; PG8_WAIT_L(0); PG8_MMA8(1, 0, At, B0); PG8_BAR; PG8_SCHED;
            PG8_STAGE(PG8_SB(1, 1), b3 + hstep, voffB);
            PG8_WAIT_V(6); PG8_BAR; PG8_MMA8(1, 1, At, B1); PG8_BAR;
            }
        }
        }
        for (int t = MIX8; t < nt; t += 2) {
            const bool last = (t == nt - 2);
            const char* a1 = cA + (size_t)(t + 1) * kstep;
            const char* a2 = last ? nA : cA + (size_t)(t + 2) * kstep; const char* b2 = last ? nB : cB + (size_t)(t + 2) * kstep;
            const char* a3 = a2 + kstep; const char* b3 = b2 + kstep;
            if (last && has_next) S.a_ready(nxt);
            if constexpr (Epi::MID) { if (t == Epi::MID_T1 || t == Epi::MID_T2) { PG8_SCHED; E.mid(acc, cur, t, wr, wc, fr, fq); PG8_SCHED; } }
            if constexpr (SP2) {
            PG8_LDB(B0, 0, 0); PG8_LDB(B1, 0, 1); PG8_SCHED; PG8_LDA(At, 0, 0); PG8_STAGE(PG8_SA(1, 1), a1 + hstep, voffA);
            PG8_WAIT_V(8); PG8_WAIT_L(0); PG8_BAR; PG8_MMA(0, 0, At, B0); PG8_MMA(0, 1, At, B1); PG8_BAR; PG8_SCHED;
            PG8_LDA(At, 0, 1); PG8_STAGE(PG8_SB(0, 0), b2, voffB); PG8_STAGE(PG8_SB(0, 1), b2 + hstep, voffB); PG8_STAGE(PG8_SA(0, 0), a2, voffA);
            PG8_WAIT_V(8); PG8_WAIT_L(0); PG8_BAR; PG8_MMA(1, 0, At, B0); PG8_MMA(1, 1, At, B1); PG8_BAR; PG8_SCHED;
            PG8_LDB(B0, 1, 0); PG8_LDB(B1, 1, 1); PG8_SCHED; PG8_LDA(At, 1, 0); PG8_STAGE(PG8_SA(0, 1), a2 + hstep, voffA);
            PG8_WAIT_V(8); PG8_WAIT_L(0); PG8_BAR; PG8_MMA(0, 0, At, B0); PG8_MMA(0, 1, At, B1); PG8_BAR; PG8_SCHED;
            PG8_LDA(At, 1, 1); PG8_STAGE(PG8_SB(1, 0), b3, voffB); PG8_STAGE(PG8_SB(1, 1), b3 + hstep, voffB); PG8_STAGE(PG8_SA(1, 0), a3, voffA);
            PG8_WAIT_V(8); PG8_WAIT_L(0); PG8_BAR; PG8_MMA(1, 0, At, B0); PG8_MMA(1, 1, At, B1); PG8_BAR; PG8_SCHED;
            } else {
            PG8_LDB(B0, 0, 0); PG8_SCHED; PG8_LDA(At, 0, 0); PG8_STAGE(PG8_SA(1, 1), a1 + hstep, voffA);
            PG8_WAIT_L(8); PG8_BAR; PG8_WAIT_L(0); PG8_MMA(0, 0, At, B0); PG8_BAR; PG8_SCHED;
            PG8_LDB(B1, 0, 1); PG8_STAGE(PG8_SB(0, 0), b2, voffB);
            PG8_BAR; PG8_WAIT_L(0); PG8_MMA(0, 1, At, B1); PG8_BAR;
            PG8_LDA(At, 0, 1); PG8_STAGE(PG8_SA(0, 0), a2, voffA);
            PG8_BAR; PG8_WAIT_L(0); PG8_MMA(1, 0, At, B0); PG8_BAR; PG8_SCHED;
            PG8_STAGE(PG8_SB(0, 1), b2 + hstep, voffB);
            PG8_WAIT_V(6); PG8_BAR; PG8_MMA(1, 1, At, B1); PG8_BAR;
            PG8_LDB(B0, 1, 0); PG8_SCHED; PG8_LDA(At, 1, 0); PG8_STAGE(PG8_SA(0, 1), a2 + hstep, voffA);
            PG8_WAIT_L(8); PG8_BAR; PG8_WAIT_L(0); PG8_MMA(0, 0, At, B0); PG8_BAR; PG8_SCHED;
            PG8_LDB(B1, 1, 1); PG8_STAGE(PG8_SB(1, 0), b3, voffB);
            PG8_BAR; PG8_WAIT_L(0); PG8_MMA(0, 1, At, B1); PG8_BAR;
            PG8_LDA(At, 1, 1); PG8_STAGE(PG8_SA(1, 0), a3, voffA);
            PG8_BAR; PG8_WAIT_L(0); PG8_MMA(1, 0, At, B0); PG8_BAR; PG8_SCHED;
            PG8_STAGE(PG8_SB(1, 1), b3 + hstep, voffB);
            PG8_WAIT_V(6); PG8_BAR; PG8_MMA(1, 1, At, B1); PG8_BAR;
            }
        }
        if constexpr (ALIGN_EPI) { if (wr == 0) PG8_BAR; }
        if constexpr (I8) {
#pragma unroll
            for (int a = 0; a < 2; ++a)
#pragma unroll
                for (int b = 0; b < 2; ++b)
#pragma unroll
                    for (int m = 0; m < 4; ++m)
#pragma unroll
                        for (int n = 0; n < 2; ++n) { const i32x4 t_ = __builtin_bit_cast(i32x4, acc[a][b][m][n]); acc[a][b][m][n] = (f32x4){(float)t_[0], (float)t_[1], (float)t_[2], (float)t_[3]}; }
            if constexpr (Epi::COLSCALE) {
                const float* wp_ = E.wsc + cur.pn * BM + wc * 32 + 8 * fq;
#pragma unroll
                for (int b = 0; b < 2; ++b)
#pragma unroll
                    for (int n = 0; n < 2; ++n) { const f32x4 s_ = *(const f32x4*)(wp_ + b * HALF + 4 * n);
#pragma unroll
                        for (int a = 0; a < 2; ++a)
#pragma unroll
                            for (int m = 0; m < 4; ++m) acc[a][b][m][n] *= s_; } } }
        if constexpr (!Epi::AFTER_DRAIN) { E(acc, cur, wr, wc, fr, fq); S.done(cur); }
        if (!has_next) break;
#pragma unroll
        for (int a = 0; a < 2; ++a)
#pragma unroll
            for (int b = 0; b < 2; ++b)
#pragma unroll
                for (int m = 0; m < 4; ++m)
#pragma unroll
                    for (int n = 0; n < 2; ++n) acc[a][b][m][n] = (f32x4){0.f, 0.f, 0.f, 0.f};
        cur = nxt; cA = nA; cB = nB; ++ui;
        if constexpr (ALIGN_EPI) { if (wr == 1) PG8_BAR; }
    }
    PG8_WAIT_V(0);
    if constexpr (!ALIGN_EPI) { if (wr == 0) PG8_BAR; }
    PG8_BAR;
    if constexpr (Epi::AFTER_DRAIN) { E.fused(acc, cur, wr, wc, fr, fq, lds, wid, lane); S.done(cur); }
#undef PG8_SA
#undef PG8_SB
#undef PG8_STAGE
#undef PG8_LDA
#undef PG8_LDB
#undef PG8_MMA
#undef PG8_WAIT_V
#undef PG8_WAIT_L
#undef PG8_BAR
#undef PG8_SCHED
}
}
namespace att {
#define ATT_LAS __attribute__((address_space(3)))
typedef unsigned short bf16_t;
using bf16x8 = __attribute__((ext_vector_type(8))) short;
using s16x4  = __attribute__((ext_vector_type(4))) short;
using f32x16 = __attribute__((ext_vector_type(16))) float;
using u32x4  = __attribute__((ext_vector_type(4))) unsigned;
constexpr int   D = 128, NW = 8, QBLK = 32, KVBLK = 64;
constexpr float SCALE = 0.088388347648318440f, LOG2E = 1.4426950408889634f;
constexpr float THR = 8.f;
constexpr int SHM_V = KVBLK * D * 2, SHM_K = KVBLK * D * 2;
constexpr int OFF_WS = 2 * SHM_V + 2 * SHM_K;
constexpr int OFF_TAB = OFF_WS + NW * 64 * 4;
constexpr int SHM_ATTN = OFF_TAB + 640 * 4;
constexpr float NEG = -1e30f;
#define KSWZ(row, colB) ((row) * 256 + ((colB) ^ (((row) & 7) << 4)))
#define SBAR() __builtin_amdgcn_sched_barrier(0)
__device__ __forceinline__ int crow(int r, int hi) { return (r & 3) + 8 * (r >> 2) + 4 * hi; }
__device__ __forceinline__ unsigned cvtpk(float lo, float hi) { unsigned r; asm volatile("v_cvt_pk_bf16_f32 %0, %1, %2" : "=v"(r) : "v"(lo), "v"(hi)); return r; }

template <bool LOG2>
__device__ __forceinline__ void partialSM(f32x16& p0, f32x16& p1, float& m_reg, float& mn, float& alpha) {
  constexpr float C = LOG2 ? 1.0f : SCALE * LOG2E;
  constexpr float TH = LOG2 ? THR * LOG2E : THR / SCALE;
  float pmax = p0[0];
#pragma unroll
  for (int r = 1; r < 16; ++r) pmax = fmaxf(pmax, p0[r]);
#pragma unroll
  for (int r = 0; r < 16; ++r) pmax = fmaxf(pmax, p1[r]);
  { auto rr = __builtin_amdgcn_permlane32_swap(__float_as_uint(pmax), __float_as_uint(pmax), false, false);
    pmax = fmaxf(__uint_as_float(rr[0]), __uint_as_float(rr[1])); }
  if (__builtin_expect(__all(pmax - m_reg <= TH), 1)) { mn = m_reg; alpha = 1.f; }
  else { mn = fmaxf(m_reg, pmax); alpha = __builtin_amdgcn_exp2f((m_reg - mn) * C); m_reg = mn; }
  float mnC = -mn * C;
#pragma unroll
  for (int r = 0; r < 16; ++r) p0[r] = fmaf(p0[r], C, mnC);
#pragma unroll
  for (int r = 0; r < 16; ++r) p1[r] = fmaf(p1[r], C, mnC);
#pragma unroll
  for (int r = 0; r < 16; ++r) p0[r] = __builtin_amdgcn_exp2f(p0[r]);
}
template <bool NOEXP = false>
__device__ __forceinline__ void finishSM(f32x16& p0, f32x16& p1, float alpha, float& l_reg, bf16x8& pa0, bf16x8& pa1, bf16x8& pa2, bf16x8& pa3) {
  if constexpr (!NOEXP) {
#pragma unroll
    for (int r = 0; r < 16; ++r) p1[r] = __builtin_amdgcn_exp2f(p1[r]); }
  typedef float f32x2_t __attribute__((ext_vector_type(2)));
  f32x2_t ps2 = {0.f, 0.f};
#pragma unroll
  for (int r = 0; r < 16; r += 2) ps2 += (f32x2_t){p0[r], p0[r + 1]};
#pragma unroll
  for (int r = 0; r < 16; r += 2) ps2 += (f32x2_t){p1[r], p1[r + 1]};
  float ps = ps2[0] + ps2[1];
  { auto rr = __builtin_amdgcn_permlane32_swap(__float_as_uint(ps), __float_as_uint(ps), false, false);
    ps = __uint_as_float(rr[0]) + __uint_as_float(rr[1]); }
  l_reg = l_reg * alpha + ps;
#define PK4(P, BASE, OUT) do { unsigned a0 = cvtpk(P[BASE + 0], P[BASE + 1]), a1 = cvtpk(P[BASE + 2], P[BASE + 3]);   \
    unsigned b0 = cvtpk(P[BASE + 4], P[BASE + 5]), b1 = cvtpk(P[BASE + 6], P[BASE + 7]);                              \
    auto r0 = __builtin_amdgcn_permlane32_swap(a0, b0, false, false); auto r1 = __builtin_amdgcn_permlane32_swap(a1, b1, false, false); \
    u32x4 w = {r0[0], r1[0], r0[1], r1[1]}; OUT = __builtin_bit_cast(bf16x8, w); } while (0)
  PK4(p0, 0, pa0); PK4(p0, 8, pa1); PK4(p1, 0, pa2); PK4(p1, 8, pa3);
#undef PK4
}
__device__ __forceinline__ void qkt(f32x16& p0, f32x16& p1, const ATT_LAS char* Ks, const bf16x8* qr, int r32, int hi) {
  p0 = f32x16{}; p1 = f32x16{};
  int ka[4];
#pragma unroll
  for (int d = 0; d < 4; ++d) ka[d] = KSWZ(r32, (d * 16 + hi * 8) * 2);
  bf16x8 c0 = *reinterpret_cast<const ATT_LAS bf16x8*>(Ks + ka[0]), c1 = *reinterpret_cast<const ATT_LAS bf16x8*>(Ks + ka[0] + 32 * 256);
#pragma unroll
  for (int d0 = 0; d0 < 8; ++d0) {
    bf16x8 n0 = c0, n1 = c1;
    if (d0 < 7) { n0 = *reinterpret_cast<const ATT_LAS bf16x8*>(Ks + ka[(d0 + 1) & 3] + ((d0 + 1) >> 2) * 128); n1 = *reinterpret_cast<const ATT_LAS bf16x8*>(Ks + ka[(d0 + 1) & 3] + ((d0 + 1) >> 2) * 128 + 32 * 256); }
    asm volatile("" : "+v"(c0), "+v"(c1) :: "memory");
    p0 = __builtin_amdgcn_mfma_f32_32x32x16_bf16(c0, qr[d0], p0, 0, 0, 0);
    p1 = __builtin_amdgcn_mfma_f32_32x32x16_bf16(c1, qr[d0], p1, 0, 0, 0);
    c0 = n0; c1 = n1; }
}
__device__ __forceinline__ void qkt_np(f32x16& p0, f32x16& p1, const ATT_LAS char* Ks, const bf16x8* qr, int r32, int hi) {
  p0 = f32x16{}; p1 = f32x16{};
  int ka[4];
#pragma unroll
  for (int d = 0; d < 4; ++d) ka[d] = KSWZ(r32, (d * 16 + hi * 8) * 2);
#pragma unroll
  for (int d0 = 0; d0 < 8; ++d0) {
    bf16x8 b0 = *reinterpret_cast<const ATT_LAS bf16x8*>(Ks + ka[d0 & 3] + (d0 >> 2) * 128);
    bf16x8 b1 = *reinterpret_cast<const ATT_LAS bf16x8*>(Ks + ka[d0 & 3] + (d0 >> 2) * 128 + 32 * 256);
    p0 = __builtin_amdgcn_mfma_f32_32x32x16_bf16(b0, qr[d0], p0, 0, 0, 0); p1 = __builtin_amdgcn_mfma_f32_32x32x16_bf16(b1, qr[d0], p1, 0, 0, 0); }
}
typedef int v8i_t __attribute__((ext_vector_type(8)));
#define K8SWZ(row, colB) ((row) * 128 + ((colB) ^ ((((row) >> 1) & 7) << 4)))
template <int SB  >
__device__ __forceinline__ void qkt8(f32x16& p0, f32x16& p1, const ATT_LAS char* Ks, const v8i_t* qf, int r32, int hi) {
  p0 = f32x16{}; p1 = f32x16{};
  const int x0 = r32 * 128 + (((2 * hi) ^ ((r32 >> 1) & 7)) << 4);
#pragma unroll
  for (int s = 0; s < 2; ++s) {
    const u32x4 k00 = *reinterpret_cast<const ATT_LAS u32x4*>(Ks + (x0 ^ (64 * s))), k01 = *reinterpret_cast<const ATT_LAS u32x4*>(Ks + (x0 ^ (64 * s) ^ 16));
    const u32x4 k10 = *reinterpret_cast<const ATT_LAS u32x4*>(Ks + (x0 ^ (64 * s)) + 4096), k11 = *reinterpret_cast<const ATT_LAS u32x4*>(Ks + (x0 ^ (64 * s) ^ 16) + 4096);
    const v8i_t ka = {(int)k00.x, (int)k00.y, (int)k00.z, (int)k00.w, (int)k01.x, (int)k01.y, (int)k01.z, (int)k01.w}, kb = {(int)k10.x, (int)k10.y, (int)k10.z, (int)k10.w, (int)k11.x, (int)k11.y, (int)k11.z, (int)k11.w};
    p0 = __builtin_amdgcn_mfma_scale_f32_32x32x64_f8f6f4(ka, qf[s], p0, 0, 0, 0, 0x7F7F7F7F, 0, SB);
    p1 = __builtin_amdgcn_mfma_scale_f32_32x32x64_f8f6f4(kb, qf[s], p1, 0, 0, 0, 0x7F7F7F7F, 0, SB); }
}
__device__ __forceinline__ void qkt_shift(f32x16& p0, f32x16& p1, const ATT_LAS char* Ks, const bf16x8* qr, const f32x16& negm, int r32, int hi) {
  int ka[4];
#pragma unroll
  for (int d = 0; d < 4; ++d) ka[d] = KSWZ(r32, (d * 16 + hi * 8) * 2);
#pragma unroll
  for (int d0 = 0; d0 < 8; ++d0) {
    bf16x8 b0 = *reinterpret_cast<const ATT_LAS bf16x8*>(Ks + ka[d0 & 3] + (d0 >> 2) * 128);
    bf16x8 b1 = *reinterpret_cast<const ATT_LAS bf16x8*>(Ks + ka[d0 & 3] + (d0 >> 2) * 128 + 32 * 256);
    if (d0 == 0) { p0 = __builtin_amdgcn_mfma_f32_32x32x16_bf16(b0, qr[d0], negm, 0, 0, 0); p1 = __builtin_amdgcn_mfma_f32_32x32x16_bf16(b1, qr[d0], negm, 0, 0, 0); }
    else { p0 = __builtin_amdgcn_mfma_f32_32x32x16_bf16(b0, qr[d0], p0, 0, 0, 0); p1 = __builtin_amdgcn_mfma_f32_32x32x16_bf16(b1, qr[d0], p1, 0, 0, 0); } }
}
__device__ __forceinline__ void partialSM_shift(f32x16& p0, f32x16& p1, float& m_reg, f32x16& negm, float& alpha, const bool fixed) {
  constexpr float TH = THR * LOG2E;
  alpha = 1.f;
  if (!fixed) {
    float pmax = p0[0];
#pragma unroll
    for (int r = 1; r < 16; ++r) pmax = fmaxf(pmax, p0[r]);
#pragma unroll
    for (int r = 0; r < 16; ++r) pmax = fmaxf(pmax, p1[r]);
    { auto rr = __builtin_amdgcn_permlane32_swap(__float_as_uint(pmax), __float_as_uint(pmax), false, false);
      pmax = fmaxf(__uint_as_float(rr[0]), __uint_as_float(rr[1])); }
    if (!__builtin_expect(__all(pmax <= TH), 1)) { const float d = fmaxf(pmax, 0.f); alpha = __builtin_amdgcn_exp2f(-d); m_reg += d;
#pragma unroll
      for (int r = 0; r < 16; ++r) { p0[r] -= d; p1[r] -= d; negm[r] = -m_reg; } }
  }
#pragma unroll
  for (int r = 0; r < 16; ++r) p0[r] = __builtin_amdgcn_exp2f(p0[r]);
}
__device__ __forceinline__ void na_hook(f32x16& p0, f32x16& p1, int kr, int qrow, int rs, int csrel, const ATT_LAS float* tabq) {
  constexpr float C = SCALE * LOG2E;
  const bool rowvalid = (kr >= rs) && (kr < rs + 8);
  if (!rowvalid) {
#pragma unroll
    for (int r = 0; r < 16; ++r) { p0[r] = NEG; p1[r] = NEG; }
  } else {
    const ATT_LAS float* tb = tabq + (kr - qrow + 7) * 32;
#pragma unroll
    for (int r = 0; r < 16; ++r) { const int kc = (r & 3) + 8 * (r >> 2);
      const float b0 = tb[kc], b1 = tb[32 + kc];
      p0[r] = ((unsigned)(kc + csrel) < 16u) ? fmaf(p0[r], C, b0) : NEG;
      p1[r] = ((unsigned)(kc + 32 + csrel) < 16u) ? fmaf(p1[r], C, b1) : NEG; }
  }
}
__device__ __forceinline__ int v_st(int k, int c) { const int kk = (k & ~0xC) | ((k & 4) << 1) | ((k & 8) >> 1); return ((kk >> 3) * 4 + (c >> 5)) * 512 + ((kk & 7) * 32 + (c & 31)) * 2; }
__device__ __forceinline__ int v_rd_base(int lane) { return ((lane & 3) << 3) | (((lane >> 2) & 3) << 6) | (((lane >> 4) & 1) << 5) | (((lane >> 5) & 1) << 8); }
constexpr int v_rd_off(int d0, int ks, int half) { return d0 * 512 + ks * 4096 + half * 2048; }
template <int OFF> __device__ __forceinline__ s16x4 tr_read(int vb) {
  s16x4 r; asm volatile("ds_read_b64_tr_b16 %0, %1 offset:%2" : "=&v"(r) : "v"(vb), "i"(OFF) : "memory"); return r;
}
template <int D0> __device__ __forceinline__ void pv_one(f32x16& od, int vb, bf16x8 pa0, bf16x8 pa1, bf16x8 pa2, bf16x8 pa3) {
  const s16x4 l0 = tr_read<v_rd_off(D0, 0, 0)>(vb), h0 = tr_read<v_rd_off(D0, 0, 1)>(vb), l1 = tr_read<v_rd_off(D0, 1, 0)>(vb), h1 = tr_read<v_rd_off(D0, 1, 1)>(vb);
  const s16x4 l2 = tr_read<v_rd_off(D0, 2, 0)>(vb), h2 = tr_read<v_rd_off(D0, 2, 1)>(vb), l3 = tr_read<v_rd_off(D0, 3, 0)>(vb), h3 = tr_read<v_rd_off(D0, 3, 1)>(vb);
#ifdef ATT_PROBE_LDS
  { const s16x4 x0 = tr_read<v_rd_off(D0, 0, 0)>(vb), x1 = tr_read<v_rd_off(D0, 0, 1)>(vb), x2 = tr_read<v_rd_off(D0, 1, 0)>(vb), x3 = tr_read<v_rd_off(D0, 1, 1)>(vb);
    const s16x4 x4 = tr_read<v_rd_off(D0, 2, 0)>(vb), x5 = tr_read<v_rd_off(D0, 2, 1)>(vb), x6 = tr_read<v_rd_off(D0, 3, 0)>(vb), x7 = tr_read<v_rd_off(D0, 3, 1)>(vb);
    asm volatile("" :: "v"(x0), "v"(x1), "v"(x2), "v"(x3), "v"(x4), "v"(x5), "v"(x6), "v"(x7)); }
#endif
  asm volatile("s_waitcnt lgkmcnt(0)" ::: "memory"); SBAR();
#define PK(L, H) (bf16x8){L[0], L[1], L[2], L[3], H[0], H[1], H[2], H[3]}
#ifdef ATT_PROBE_VALU
#define PVX() do { _Pragma("unroll") for (int i_ = 0; i_ < ATT_PROBE_VALU; ++i_) asm volatile("v_exp_f32 %0, %0" : "+v"(dmy_)); } while (0)
  float dmy_ = 1.0f;
#else
#define PVX() do { } while (0)
#endif
  od = __builtin_amdgcn_mfma_f32_32x32x16_bf16(pa0, PK(l0, h0), od, 0, 0, 0); PVX();
  od = __builtin_amdgcn_mfma_f32_32x32x16_bf16(pa1, PK(l1, h1), od, 0, 0, 0); PVX();
  od = __builtin_amdgcn_mfma_f32_32x32x16_bf16(pa2, PK(l2, h2), od, 0, 0, 0); PVX();
  od = __builtin_amdgcn_mfma_f32_32x32x16_bf16(pa3, PK(l3, h3), od, 0, 0, 0); PVX();
#undef PVX
#ifdef ATT_PROBE_MFMA
  { const bf16x8 z8 = {0, 0, 0, 0, 0, 0, 0, 0}; od = __builtin_amdgcn_mfma_f32_32x32x16_bf16(z8, PK(l0, h0), od, 0, 0, 0); od = __builtin_amdgcn_mfma_f32_32x32x16_bf16(z8, PK(l1, h1), od, 0, 0, 0);
    od = __builtin_amdgcn_mfma_f32_32x32x16_bf16(z8, PK(l2, h2), od, 0, 0, 0); od = __builtin_amdgcn_mfma_f32_32x32x16_bf16(z8, PK(l3, h3), od, 0, 0, 0); }
#endif
#undef PK
}
#ifndef PV_PREFETCH
#define PV_PREFETCH 0
#endif
struct VFrag { s16x4 l0, h0, l1, h1, l2, h2, l3, h3; };
template <int D0> __device__ __forceinline__ void pv_read(VFrag& f, int vb) {
  f.l0 = tr_read<v_rd_off(D0, 0, 0)>(vb); f.h0 = tr_read<v_rd_off(D0, 0, 1)>(vb); f.l1 = tr_read<v_rd_off(D0, 1, 0)>(vb); f.h1 = tr_read<v_rd_off(D0, 1, 1)>(vb);
  f.l2 = tr_read<v_rd_off(D0, 2, 0)>(vb); f.h2 = tr_read<v_rd_off(D0, 2, 1)>(vb); f.l3 = tr_read<v_rd_off(D0, 3, 0)>(vb); f.h3 = tr_read<v_rd_off(D0, 3, 1)>(vb);
}
__device__ __forceinline__ void pv_mma(f32x16& od, const VFrag& f, bf16x8 pa0, bf16x8 pa1, bf16x8 pa2, bf16x8 pa3) {
#define PK(L, H) (bf16x8){L[0], L[1], L[2], L[3], H[0], H[1], H[2], H[3]}
  od = __builtin_amdgcn_mfma_f32_32x32x16_bf16(pa0, PK(f.l0, f.h0), od, 0, 0, 0);
  od = __builtin_amdgcn_mfma_f32_32x32x16_bf16(pa1, PK(f.l1, f.h1), od, 0, 0, 0);
  od = __builtin_amdgcn_mfma_f32_32x32x16_bf16(pa2, PK(f.l2, f.h2), od, 0, 0, 0);
  od = __builtin_amdgcn_mfma_f32_32x32x16_bf16(pa3, PK(f.l3, f.h3), od, 0, 0, 0);
#undef PK
}
#ifndef EXPV
#define EXPV 0
#endif
template <int NE, int D0> __device__ __forceinline__ void pv_exp_one(f32x16& od, int vb, bf16x8 pa0, bf16x8 pa1, bf16x8 pa2, bf16x8 pa3, f32x16& s0, f32x16& s1) {
  const s16x4 l0 = tr_read<v_rd_off(D0, 0, 0)>(vb), h0 = tr_read<v_rd_off(D0, 0, 1)>(vb), l1 = tr_read<v_rd_off(D0, 1, 0)>(vb), h1 = tr_read<v_rd_off(D0, 1, 1)>(vb);
  const s16x4 l2 = tr_read<v_rd_off(D0, 2, 0)>(vb), h2 = tr_read<v_rd_off(D0, 2, 1)>(vb), l3 = tr_read<v_rd_off(D0, 3, 0)>(vb), h3 = tr_read<v_rd_off(D0, 3, 1)>(vb);
  asm volatile("s_waitcnt lgkmcnt(0)" ::: "memory"); SBAR();
#define PK(L, H) (bf16x8){L[0], L[1], L[2], L[3], H[0], H[1], H[2], H[3]}
#define EX(i) do { asm volatile("v_exp_f32 %0, %0" : "+v"(s0[D0 * 4 + i])); if constexpr (NE == 32) asm volatile("v_exp_f32 %0, %0" : "+v"(s1[D0 * 4 + i])); } while (0)
  od = __builtin_amdgcn_mfma_f32_32x32x16_bf16(pa0, PK(l0, h0), od, 0, 0, 0); EX(0);
  od = __builtin_amdgcn_mfma_f32_32x32x16_bf16(pa1, PK(l1, h1), od, 0, 0, 0); EX(1);
  od = __builtin_amdgcn_mfma_f32_32x32x16_bf16(pa2, PK(l2, h2), od, 0, 0, 0); EX(2);
  od = __builtin_amdgcn_mfma_f32_32x32x16_bf16(pa3, PK(l3, h3), od, 0, 0, 0); EX(3);
#undef EX
#undef PK
}
template <int NE> __device__ __forceinline__ void pv_exp(f32x16* o, int vb, bf16x8 pa0, bf16x8 pa1, bf16x8 pa2, bf16x8 pa3, f32x16& s0, f32x16& s1) {
  pv_exp_one<NE, 0>(o[0], vb, pa0, pa1, pa2, pa3, s0, s1); pv_exp_one<NE, 1>(o[1], vb, pa0, pa1, pa2, pa3, s0, s1);
  pv_exp_one<NE, 2>(o[2], vb, pa0, pa1, pa2, pa3, s0, s1); pv_exp_one<NE, 3>(o[3], vb, pa0, pa1, pa2, pa3, s0, s1);
}
template <bool PF> __device__ __forceinline__ void pv_d0(f32x16* o, int vb, bf16x8 pa0, bf16x8 pa1, bf16x8 pa2, bf16x8 pa3) {
  if constexpr (PF) {
  VFrag fa, fb;
  pv_read<0>(fa, vb);
  pv_read<1>(fb, vb); asm volatile("s_waitcnt lgkmcnt(8)" ::: "memory"); SBAR(); pv_mma(o[0], fa, pa0, pa1, pa2, pa3); SBAR();
  pv_read<2>(fa, vb); asm volatile("s_waitcnt lgkmcnt(8)" ::: "memory"); SBAR(); pv_mma(o[1], fb, pa0, pa1, pa2, pa3); SBAR();
  pv_read<3>(fb, vb); asm volatile("s_waitcnt lgkmcnt(8)" ::: "memory"); SBAR(); pv_mma(o[2], fa, pa0, pa1, pa2, pa3); SBAR();
  asm volatile("s_waitcnt lgkmcnt(0)" ::: "memory"); SBAR(); pv_mma(o[3], fb, pa0, pa1, pa2, pa3);
  } else {
  pv_one<0>(o[0], vb, pa0, pa1, pa2, pa3); pv_one<1>(o[1], vb, pa0, pa1, pa2, pa3); pv_one<2>(o[2], vb, pa0, pa1, pa2, pa3); pv_one<3>(o[3], vb, pa0, pa1, pa2, pa3); }
}

__device__ __forceinline__ void psm8(f32x16& p0, f32x16& p1, float& e0, float& e1, const int hi) {
  float m0 = p0[0], m1 = p1[0];
#pragma unroll
  for (int r = 1; r < 15; r += 2) { m0 = __builtin_fmaxf(__builtin_fmaxf(m0, p0[r]), p0[r + 1]); m1 = __builtin_fmaxf(__builtin_fmaxf(m1, p1[r]), p1[r + 1]); }
  float M = fmaxf(fmaxf(m0, p0[15]), fmaxf(m1, p1[15]));
  { const auto rr = __builtin_amdgcn_permlane32_swap(__float_as_uint(M), __float_as_uint(M), false, false); M = fmaxf(__uint_as_float(rr[0]), __uint_as_float(rr[1])); }
  e0 = e1 = __builtin_ceilf(M) - 7.0f;
#pragma unroll
  for (int r = 0; r < 16; ++r) p0[r] = __builtin_amdgcn_exp2f(p0[r]);
}
#ifndef CVT_DIV
#define CVT_DIV 1
#endif
__device__ __forceinline__ void fsm8(f32x16& p0, f32x16& p1, const float e0, const float e1, float& l_reg, v8i_t& pf, int& psc, const int hi) {
#pragma unroll
  for (int r = 0; r < 16; ++r) p1[r] = __builtin_amdgcn_exp2f(p1[r]);
  typedef short v2s_t __attribute__((ext_vector_type(2)));
  const int eb = (int)e0 + 127;
  const float sc = __uint_as_float((unsigned)(CVT_DIV ? eb : 254 - eb) << 23);
#pragma unroll
  for (int g = 0; g < 4; ++g) { v2s_t a0 = {0, 0}, a1 = {0, 0};
    a0 = __builtin_amdgcn_cvt_scalef32_pk_fp8_f32(a0, p0[4 * g], p0[4 * g + 1], sc, false); a0 = __builtin_amdgcn_cvt_scalef32_pk_fp8_f32(a0, p0[4 * g + 2], p0[4 * g + 3], sc, true);
    a1 = __builtin_amdgcn_cvt_scalef32_pk_fp8_f32(a1, p1[4 * g], p1[4 * g + 1], sc, false); a1 = __builtin_amdgcn_cvt_scalef32_pk_fp8_f32(a1, p1[4 * g + 2], p1[4 * g + 3], sc, true);
    const auto rr = __builtin_amdgcn_permlane32_swap(__builtin_bit_cast(unsigned, a0), __builtin_bit_cast(unsigned, a1), false, false);
    pf[2 * g] = (int)rr[0]; pf[2 * g + 1] = (int)rr[1]; }
  psc = eb | (eb << 8) | (eb << 16) | (eb << 24);
}
__device__ __forceinline__ void pv8(f32x16* o, f32x16& lacc, const ATT_LAS char* Vt, const v8i_t pf, const int psc, const int r32, const int hi) {
#ifdef ONES_LIVE
  { const v8i_t ones = {0x38383838, 0x38383838, 0x38383838, 0x38383838, 0x38383838, 0x38383838, 0x38383838, 0x38383838};
#else
  { int o1_ = 0x38383838; asm volatile("" : "+v"(o1_));            const v8i_t ones = {o1_, o1_, o1_, o1_, o1_, o1_, o1_, o1_};
#endif
    lacc = __builtin_amdgcn_mfma_scale_f32_32x32x64_f8f6f4(pf, ones, lacc, 0, 0, 0, psc, 0, 0x7F7F7F7F); }
  const int a0 = r32 * 64 + (((2 * hi) ^ ((r32 >> 2) & 3)) << 4);
#pragma unroll
  for (int cb = 0; cb < 4; ++cb) {
    const u32x4 x = *reinterpret_cast<const ATT_LAS u32x4*>(Vt + cb * 2048 + a0), y = *reinterpret_cast<const ATT_LAS u32x4*>(Vt + cb * 2048 + (a0 ^ 16));
    const v8i_t vf = {(int)x.x, (int)x.y, (int)x.z, (int)x.w, (int)y.x, (int)y.y, (int)y.z, (int)y.w};
    o[cb] = __builtin_amdgcn_mfma_scale_f32_32x32x64_f8f6f4(pf, vf, o[cb], 0, 0, 0, psc, 0, 0x7F7F7F7F); }
}

template <bool NA, bool FIXED, int SDEPTH, int LDQ, int LDK, int LDO, bool K8 = false, int LDK8 = 128  , bool O8 = false  , bool V8 = false  , int LDV8 = 8192>
__device__ __forceinline__ void attn_unit(const bf16_t* __restrict__ Qb, const bf16_t* __restrict__ Kb, const bf16_t* __restrict__ Vb, bf16_t* __restrict__ Ob,
                                          int NT, int krow0, int r0, const float* __restrict__ rpb, const float* __restrict__ qg, const float* __restrict__ ropet, int qtok0, const float kmax  , ATT_LAS char* lds, const int wave) {
  int tid_ = wave * 64 + lane_id(); asm volatile("" : "+v"(tid_));
  const int tid = tid_, wid = __builtin_amdgcn_readfirstlane(tid >> 6), lane = tid & 63, r32 = lane & 31, hi = lane >> 5;
  ATT_LAS char* V_lds = lds; ATT_LAS char* K_lds = lds + 2 * SHM_V;
  ATT_LAS float* ws = (ATT_LAS float*)(lds + OFF_WS) + wid * 64; ATT_LAS float* li_l = ws; ATT_LAS float* al_l = ws + 32;
  ATT_LAS float* tab = (ATT_LAS float*)(lds + OFF_TAB);
  __syncthreads();
#ifndef ATT_PRIO
#define ATT_PRIO 1
#endif
#if ATT_PRIO
#ifndef ATT_PRIO_HALF
#define ATT_PRIO_HALF 0
#endif
  if (ATT_PRIO_HALF ? (wid < 4) : (wid >= 4)) __builtin_amdgcn_s_setprio(ATT_PRIO);
#endif
  const int qrow = r0 + (wid >> 1), qc = (wid & 1) * 32 + r32;
  const int rs = min(max(qrow - 4, 0), 120), cs = min(max(qc - 8, 0), 48), csrel = 4 * hi - cs;
  const ATT_LAS float* tabq = tab + 64 + 15 - qc + 4 * hi;
  if constexpr (NA) { for (int i = tid; i < 15 * 32; i += 64 * NW) { const int rr = i >> 5, cc = i & 31; tab[64 + i] = (cc < 31) ? rpb[rr * 31 + cc] * LOG2E : 0.f; } }
  float m_reg = NA ? NEG : -64.0f, l_reg = 0; f32x16 o[4] = {}; bf16x8 qr[8];
  f32x16 negm; if constexpr (!NA) {
#pragma unroll
    for (int r = 0; r < 16; ++r) negm[r] = 64.0f; }
#define QP(d0) (K8 ? 64 * ((d0) >> 2) + 32 * hi + 8 * ((d0) & 3) : (d0) * 16 + hi * 8)
  const bf16_t* Qw = Qb + (long)(wid * QBLK + r32) * LDQ;
#pragma unroll
  for (int d0 = 0; d0 < 8; ++d0) qr[d0] = *reinterpret_cast<const bf16x8*>(Qw + QP(d0));
  v8i_t qf[2];
  if constexpr (!NA) {
    typedef float f32x4_t __attribute__((ext_vector_type(4)));
    float xv[8][8]; float ss = 0.f;
#pragma unroll
    for (int d0 = 0; d0 < 8; ++d0) { const u32x4 w = __builtin_bit_cast(u32x4, qr[d0]);
      xv[d0][0] = __uint_as_float(w.x << 16); xv[d0][1] = __uint_as_float(w.x & 0xffff0000u); xv[d0][2] = __uint_as_float(w.y << 16); xv[d0][3] = __uint_as_float(w.y & 0xffff0000u);
      xv[d0][4] = __uint_as_float(w.z << 16); xv[d0][5] = __uint_as_float(w.z & 0xffff0000u); xv[d0][6] = __uint_as_float(w.w << 16); xv[d0][7] = __uint_as_float(w.w & 0xffff0000u);
#pragma unroll
      for (int j = 0; j < 8; ++j) ss += xv[d0][j] * xv[d0][j]; }
    { auto rr = __builtin_amdgcn_permlane32_swap(__float_as_uint(ss), __float_as_uint(ss), false, false); ss = __uint_as_float(rr[0]) + __uint_as_float(rr[1]); }
    const float rstd = __builtin_amdgcn_rsqf(ss * (1.0f / 128.0f) + 1e-6f);
    const int tq = qtok0 + wid * QBLK + r32;
    constexpr float QS = K8 ? SCALE * LOG2E * 8.0f : SCALE * LOG2E;
#pragma unroll
    for (int d0 = 0; d0 < 8; ++d0) { const int qp = QP(d0), half = K8 ? (d0 >> 2) : (d0 >> 2), i0 = (qp & 63) >> 1; const int pos = half == 0 ? (tq >> 6) : 128 + (tq & 63);
      const f32x4_t gA = *(const f32x4_t*)(qg + 64 * half + i0), gB = *(const f32x4_t*)(qg + 64 * half + 32 + i0);
      const float* cs = ropet + ((size_t)pos * 32 + i0) * 2; const f32x4_t c0 = *(const f32x4_t*)(cs), c1 = *(const f32x4_t*)(cs + 4);
      const float cc[4] = {c0[0], c0[2], c1[0], c1[2]}, sn[4] = {c0[1], c0[3], c1[1], c1[3]};
#pragma unroll
      for (int t = 0; t < 4; ++t) { const float x1 = xv[d0][2 * t] * rstd * gA[t], x2 = xv[d0][2 * t + 1] * rstd * gB[t];
        xv[d0][2 * t] = (x1 * cc[t] - x2 * sn[t]) * QS; xv[d0][2 * t + 1] = (x1 * sn[t] + x2 * cc[t]) * QS; } }
    if constexpr (K8) {
#pragma unroll
      for (int d0 = 0; d0 < 8; ++d0) { int w0 = 0, w1 = 0;
        w0 = __builtin_amdgcn_cvt_pk_fp8_f32(xv[d0][0], xv[d0][1], w0, false); w0 = __builtin_amdgcn_cvt_pk_fp8_f32(xv[d0][2], xv[d0][3], w0, true);
        w1 = __builtin_amdgcn_cvt_pk_fp8_f32(xv[d0][4], xv[d0][5], w1, false); w1 = __builtin_amdgcn_cvt_pk_fp8_f32(xv[d0][6], xv[d0][7], w1, true);
        qf[d0 >> 2][2 * (d0 & 3)] = w0; qf[d0 >> 2][2 * (d0 & 3) + 1] = w1; }
    } else {
#pragma unroll
    for (int d0 = 0; d0 < 8; ++d0) { u32x4 w = {cvtpk(xv[d0][0], xv[d0][1]), cvtpk(xv[d0][2], xv[d0][3]), cvtpk(xv[d0][4], xv[d0][5]), cvtpk(xv[d0][6], xv[d0][7])}; qr[d0] = __builtin_bit_cast(bf16x8, w); }
    }
  }
  if constexpr (NA && K8) {
#pragma unroll
    for (int d0 = 0; d0 < 8; ++d0) { const u32x4 w = __builtin_bit_cast(u32x4, qr[d0]); int w0 = 0, w1 = 0;
      w0 = __builtin_amdgcn_cvt_pk_fp8_f32(__uint_as_float(w.x << 16), __uint_as_float(w.x & 0xffff0000u), w0, false); w0 = __builtin_amdgcn_cvt_pk_fp8_f32(__uint_as_float(w.y << 16), __uint_as_float(w.y & 0xffff0000u), w0, true);
      w1 = __builtin_amdgcn_cvt_pk_fp8_f32(__uint_as_float(w.z << 16), __uint_as_float(w.z & 0xffff0000u), w1, false); w1 = __builtin_amdgcn_cvt_pk_fp8_f32(__uint_as_float(w.w << 16), __uint_as_float(w.w & 0xffff0000u), w1, true);
      qf[d0 >> 2][2 * (d0 & 3)] = w0; qf[d0 >> 2][2 * (d0 & 3) + 1] = w1; }
  }
#undef QP
  const int sr = tid >> 4, sc = (tid & 15) * 8, vst0 = v_st(sr, sc), vst1 = v_st(32 + sr, sc);
  const int vb0 = (int)(unsigned)(uintptr_t)V_lds + v_rd_base(lane);
  struct { bf16x8 vs0, vs1, ks0, ks1; } sr_[SDEPTH];
#define TILE_TOK(t) (NA ? (min(krow0 + (t), 127) * 64) : ((t) * 64))
  typedef const __attribute__((address_space(1))) char* gcp;
  const unsigned lof0 = (unsigned)(sr * LDK + sc) * 2u, lof1 = lof0 + 32u * LDK * 2u;
  const int v8st = (tid >> 2) * 64 + (((tid & 3) ^ ((tid >> 4) & 3)) << 4);
  const int k8st = K8SWZ(tid >> 3, (tid & 7) * 16);
#define SLOAD(i, t) do { const long tb_ = (long)TILE_TOK(t) * (LDK * 2); gcp kt_ = (gcp)Kb + tb_; gcp vt_ = (gcp)Vb + tb_; \
    if constexpr (V8) { sr_[i].vs0 = *(const __attribute__((address_space(1))) bf16x8*)((gcp)Vb + (long)(tid >> 2) * LDV8 + TILE_TOK(t) + (tid & 3) * 16); } \
    else { sr_[i].vs0 = *(const __attribute__((address_space(1))) bf16x8*)(vt_ + lof0); sr_[i].vs1 = *(const __attribute__((address_space(1))) bf16x8*)(vt_ + lof1); } \
    if constexpr (K8) { sr_[i].ks0 = *(const __attribute__((address_space(1))) bf16x8*)((gcp)Kb + (long)(TILE_TOK(t) + (tid >> 3)) * LDK8 + (tid & 7) * 16); } \
    else { sr_[i].ks0 = *(const __attribute__((address_space(1))) bf16x8*)(kt_ + lof0); sr_[i].ks1 = *(const __attribute__((address_space(1))) bf16x8*)(kt_ + lof1); } } while (0)
#define SWRITE(b, i) do { if constexpr (V8) { *(ATT_LAS bf16x8*)(V_lds + (b) * SHM_V + v8st) = sr_[i].vs0; } else { *(ATT_LAS bf16x8*)(V_lds + (b) * SHM_V + vst0) = sr_[i].vs0;          \
    *(ATT_LAS bf16x8*)(V_lds + (b) * SHM_V + vst1) = sr_[i].vs1; } int kc_ = sc * 2;               \
    if constexpr (K8) { *(ATT_LAS bf16x8*)(K_lds + (b) * SHM_K + k8st) = sr_[i].ks0; } else {    \
    *(ATT_LAS bf16x8*)(K_lds + (b) * SHM_K + KSWZ(sr, kc_)) = sr_[i].ks0;                       \
    *(ATT_LAS bf16x8*)(K_lds + (b) * SHM_K + KSWZ(32 + sr, kc_)) = sr_[i].ks1; } } while (0)
#define SWAIT() do { if constexpr (SDEPTH == 2 && K8 && V8) asm volatile("s_waitcnt vmcnt(2)" ::: "memory"); else if constexpr (SDEPTH == 2 && K8) asm volatile("s_waitcnt vmcnt(3)" ::: "memory"); else if constexpr (SDEPTH == 2) asm volatile("s_waitcnt vmcnt(4)" ::: "memory"); else asm volatile("s_waitcnt vmcnt(0)" ::: "memory"); } while (0)
#define RESC(a) do { if constexpr (NA || !FIXED) if (__any((a) < 1.f)) { if (hi == 0) al_l[r32] = (a); asm volatile("s_waitcnt lgkmcnt(0)" ::: "memory"); \
    _Pragma("unroll") for (int d = 0; d < 4; ++d) _Pragma("unroll") for (int r = 0; r < 16; ++r) o[d][r] *= al_l[crow(r, hi)]; } } while (0)
#define HOOK(P0, P1, t) do { if constexpr (NA) na_hook(P0, P1, krow0 + (t), qrow, rs, csrel, tabq); } while (0)
#define QKT(P0, P1, KS) do { if constexpr (K8) qkt8<NA ? 0x7F7F7F7F : 0x7C7C7C7C>(P0, P1, KS, qf, r32, hi); else if constexpr (NA && NA_SKIP) qkt_np(P0, P1, KS, qr, r32, hi); else if constexpr (NA || FIXED) qkt(P0, P1, KS, qr, r32, hi); else qkt_shift(P0, P1, KS, qr, negm, r32, hi); } while (0)
#define PSM(P0, P1, MN, AL) do { if constexpr (V8) psm8(P0, P1, MN, AL, hi); else if constexpr (NA) partialSM<true>(P0, P1, m_reg, MN, AL); else if constexpr (FIXED) { AL = 1.f; _Pragma("unroll") for (int r_ = 0; r_ < 16; ++r_) P0[r_] = __builtin_amdgcn_exp2f(P0[r_]); } else partialSM_shift(P0, P1, m_reg, negm, AL, false); } while (0)
  constexpr bool PVPF = (PV_PREFETCH & 1) ? (!NA && FIXED) : (PV_PREFETCH & 2) ? NA : (PV_PREFETCH & 4) ? (NA || FIXED) : false;
  constexpr int NEV = (!NA && FIXED) ? EXPV : 0;
#define PVONLY(VB) do { if constexpr (V8) pv8(o, lacc, V_lds + ((VB) - vb0), pf, psc, r32, hi); else pv_d0<PVPF>(o, VB, pa0, pa1, pa2, pa3); } while (0)
#define PVS(VB, P0, P1, t, MN, AL) do { if constexpr (V8) { pv8(o, lacc, V_lds + ((VB) - vb0), pf, psc, r32, hi); psm8(P0, P1, MN, AL, hi); } else if constexpr (NEV != 0) { pv_exp<NEV == 0 ? 16 : NEV>(o, VB, pa0, pa1, pa2, pa3, P0, P1); AL = 1.f; } else { pv_d0<PVPF>(o, VB, pa0, pa1, pa2, pa3); HOOK(P0, P1, t); PSM(P0, P1, MN, AL); } } while (0)
#ifndef NA_SKIP
#define NA_SKIP 0
#endif
#define TV(t) (!(NA && NA_SKIP) || (__builtin_amdgcn_readfirstlane((int)(((krow0 + (t)) >= rs && (krow0 + (t)) < rs + 8))) != 0))
#define FSM(P0, P1, MN, AL) do { if constexpr (V8) fsm8(P0, P1, MN, AL, l_reg, pf, psc, hi); else finishSM<NEV == 32>(P0, P1, AL, l_reg, pa0, pa1, pa2, pa3); } while (0)
  f32x16 pA0, pA1, pB0, pB1; float mnA, mnB, alA, alB; bf16x8 pa0, pa1, pa2, pa3; v8i_t pf; int psc; f32x16 lacc = {};
  constexpr int SE = 0, SO = SDEPTH - 1;
  SLOAD(SE, 0); asm volatile("s_waitcnt vmcnt(0)" ::: "memory"); SWRITE(0, SE); __syncthreads();
  alA = 1.f; if (TV(0)) { QKT(pA0, pA1, K_lds); HOOK(pA0, pA1, 0); PSM(pA0, pA1, mnA, alA); }
  if constexpr (NEV == 32) {
#pragma unroll
    for (int r_ = 0; r_ < 16; ++r_) pA1[r_] = __builtin_amdgcn_exp2f(pA1[r_]); }
  SLOAD(SO, 1); if constexpr (SDEPTH == 2) { if (2 < NT) SLOAD(SE, 2); }
  SWAIT(); SWRITE(1, SO); __syncthreads();
#ifndef ATT_ANTI
#define ATT_ANTI 0
#endif
  constexpr bool ANTI = ATT_ANTI && !NA && FIXED;
  if (!ANTI || wid < 4) {
  for (int j = 1; j + 1 < NT; j += 2) {
    if constexpr (NA && NA_SKIP) {
    const bool v0_ = TV(j - 1), v1_ = TV(j), v2_ = TV(j + 1);
    SBAR(); if (v1_) QKT(pB0, pB1, K_lds + SHM_K);
    if (v0_) FSM(pA0, pA1, mnA, alA); SBAR();
    SLOAD(SO, j + SDEPTH); SBAR();
    if (v0_) PVONLY(vb0); alB = 1.f; if (v1_) { HOOK(pB0, pB1, j); PSM(pB0, pB1, mnB, alB); }
    __syncthreads(); SWAIT(); SWRITE(0, SE);
    RESC(alB); __syncthreads();
    SBAR(); if (v2_) QKT(pA0, pA1, K_lds);
    if (v1_) FSM(pB0, pB1, mnB, alB); SBAR();
    if (SDEPTH == 1 || j + 3 < NT) SLOAD(SE, j + 1 + SDEPTH); SBAR();
    if (v1_) PVONLY(vb0 + SHM_V); alA = 1.f; if (v2_) { HOOK(pA0, pA1, j + 1); PSM(pA0, pA1, mnA, alA); }
    __syncthreads(); SWAIT(); SWRITE(1, SO);
    RESC(alA); __syncthreads();
    } else {
    SBAR(); QKT(pB0, pB1, K_lds + SHM_K);
    FSM(pA0, pA1, mnA, alA); SBAR();
    SLOAD(SO, j + SDEPTH); SBAR();
    PVS(vb0, pB0, pB1, j, mnB, alB);
    __syncthreads(); SWAIT(); SWRITE(0, SE);
    RESC(alB); __syncthreads();
    SBAR(); QKT(pA0, pA1, K_lds);
    FSM(pB0, pB1, mnB, alB); SBAR();
    if (SDEPTH == 1 || j + 3 < NT) SLOAD(SE, j + 1 + SDEPTH); SBAR();
    PVS(vb0 + SHM_V, pA0, pA1, j + 1, mnA, alA);
    __syncthreads(); SWAIT(); SWRITE(1, SO);
    RESC(alA); __syncthreads();
    }
  }
  } else {
  for (int j = 1; j + 1 < NT; j += 2) {
    SBAR(); FSM(pA0, pA1, mnA, alA); SBAR();
    SLOAD(SO, j + SDEPTH); SBAR();
    pv_d0<PVPF>(o, vb0, pa0, pa1, pa2, pa3); SBAR();
    qkt_np(pB0, pB1, K_lds + SHM_K, qr, r32, hi); HOOK(pB0, pB1, j); PSM(pB0, pB1, mnB, alB);
    __syncthreads(); SWAIT(); SWRITE(0, SE);
    RESC(alB); __syncthreads();
    SBAR(); FSM(pB0, pB1, mnB, alB); SBAR();
    if (SDEPTH == 1 || j + 3 < NT) SLOAD(SE, j + 1 + SDEPTH); SBAR();
    pv_d0<PVPF>(o, vb0 + SHM_V, pa0, pa1, pa2, pa3); SBAR();
    qkt_np(pA0, pA1, K_lds, qr, r32, hi); HOOK(pA0, pA1, j + 1); PSM(pA0, pA1, mnA, alA);
    __syncthreads(); SWAIT(); SWRITE(1, SO);
    RESC(alA); __syncthreads();
  }
  }
  if constexpr (NA && NA_SKIP) {
  const bool v0_ = TV(NT - 2), v1_ = TV(NT - 1);
  SBAR(); if (v1_) QKT(pB0, pB1, K_lds + SHM_K);
  if (v0_) FSM(pA0, pA1, mnA, alA); SBAR();
  if (v0_) PVONLY(vb0); alB = 1.f; if (v1_) { HOOK(pB0, pB1, NT - 1); PSM(pB0, pB1, mnB, alB); }
  __syncthreads(); RESC(alB);
  if (v1_) { FSM(pB0, pB1, mnB, alB); SBAR(); PVONLY(vb0 + SHM_V); }
  } else if constexpr (NA) {
  FSM(pA0, pA1, mnA, alA); SBAR();
  PVONLY(vb0);
  } else {
  SBAR(); QKT(pB0, pB1, K_lds + SHM_K);
  FSM(pA0, pA1, mnA, alA); SBAR();
  PVS(vb0, pB0, pB1, NT - 1, mnB, alB);
  __syncthreads(); RESC(alB);
  FSM(pB0, pB1, mnB, alB); SBAR();
  PVONLY(vb0 + SHM_V);
  }

#if ATT_PRIO
  __builtin_amdgcn_s_setprio(0);
#endif
  if (hi == 0) li_l[r32] = l_reg; asm volatile("s_waitcnt lgkmcnt(0)" ::: "memory");
  float rli[16];
#pragma unroll
  for (int r = 0; r < 16; ++r) rli[r] = __builtin_amdgcn_rcpf(V8 ? lacc[r] : li_l[crow(r, hi)]) * (O8 ? 16.0f : 1.0f);
  bf16_t* Ow = O8 ? (bf16_t*)((unsigned char*)Ob + (long)(wid * QBLK) * LDO) : Ob + (long)(wid * QBLK) * LDO;
#pragma unroll
  for (int r = 0; r < 16; ++r) { const int orow = crow(r, hi);
#pragma unroll
    for (int d0 = 0; d0 < 4; ++d0) { const float v = o[d0][r] * rli[r];
      if constexpr (O8) { int w_ = 0; const float v16 = fminf(fmaxf(v, -448.0f), 448.0f);     w_ = __builtin_amdgcn_cvt_pk_fp8_f32(v16, v16, w_, false); ((unsigned char*)Ow)[(long)orow * LDO + d0 * 32 + r32] = (unsigned char)(w_ & 0xff); }
      else Ow[(long)orow * LDO + d0 * 32 + r32] = (bf16_t)(cvtpk(v, v) & 0xffffu); } }
#undef TILE_TOK
#undef SLOAD
#undef SWRITE
#undef SWAIT
#undef RESC
#undef HOOK
#undef QKT
#undef PSM
#undef PVS
#undef PVONLY
#undef TV
#undef FSM
}
#undef KSWZ
#undef K8SWZ
#undef SBAR
}
constexpr int NWAVES = 8;
constexpr int BATCH = 2, SEQ = 8192, DM = 2048, DEPTH = 4, GRIDW = 64, HD = 128;
constexpr int M = BATCH * SEQ;
constexpr int INC = 13824, FF = 5632, NGU = 2 * FF;
constexpr int C_NAQ = 0, C_NAK = 1024, C_NAV = 2048, C_GQ = 3072, C_GK = 4096, C_GV = 4352, C_CH = 4608, C_CB = 5632, C_CC = 6656, C_GNA = 7680, C_GGQ = 9728, C_GCV = 11776;
constexpr float RMS_EPS = 1e-6f;
constexpr size_t MiB = 1u << 20;
constexpr size_t WS_CTL = 0, CTL_ZERO_BYTES = 1 * MiB;
constexpr size_t WS_ROPE = 1 * MiB;
constexpr size_t WS_WIN = 2 * MiB,    SZ_WIN = 54 * MiB;
constexpr size_t WS_WBR = 218 * MiB,  SZ_WBR = 4 * MiB;
constexpr size_t WS_WOUT = 266 * MiB, SZ_WOUT = 8 * MiB;
constexpr size_t WS_WGU = 298 * MiB,  SZ_WGU = 44 * MiB;
constexpr size_t WS_WDN = 474 * MiB,  SZ_WDN = 22 * MiB;
constexpr size_t WS_H = 562 * MiB;
constexpr size_t WS_SSX = WS_ROPE + 65536;
constexpr size_t WS_PROJ = 626 * MiB;
constexpr size_t WS_ACT = WS_PROJ;
constexpr size_t WS_ANA = 1058 * MiB, WS_AGQ = 1090 * MiB, WS_ACV = 1122 * MiB;
constexpr size_t WS_MRG = 1154 * MiB;
constexpr size_t WS_T = 1218 * MiB;
constexpr size_t WS_G8 = 1282 * MiB;
constexpr int NQKV = C_CH, NI8 = NQKV + (INC - C_GNA);
constexpr size_t WS_WG8 = 1378 * MiB, SZ_WG8 = (size_t)NI8 * 2048;
constexpr size_t WS_XB8 = WS_WG8 + 4 * SZ_WG8;
constexpr size_t WS_ASC = WS_ROPE + 131072;
constexpr size_t WS_WSC = WS_ROPE + 262144;
constexpr size_t WS_WGU8 = WS_XB8 + 32 * MiB, SZ_WGU8 = 22 * MiB;
constexpr size_t WS_WSCF = WS_ROPE + 524288;
constexpr size_t WS_WBR8 = WS_WGU8 + 4 * SZ_WGU8, SZ_WBR8 = 8 * MiB;
constexpr size_t WS_WSB = WS_ROPE + 786432;
constexpr size_t WS_END = WS_WBR8 + 4 * SZ_WBR8;
static_assert(WS_WSC + (size_t)4 * NI8 * 4 <= WS_WSCF && WS_WSCF + (size_t)4 * 11264 * 4 <= WS_WIN && SZ_WG8 % MiB == 0, "scale tables inside the rope MiB");
static_assert(SZ_WIN == (size_t)INC * DM * 2 && SZ_WGU == (size_t)NGU * DM * 2 && SZ_WDN == (size_t)DM * FF * 2 && WS_WIN + 4 * SZ_WIN == WS_WBR && WS_WBR + 12 * SZ_WBR == WS_WOUT && WS_WOUT + 4 * SZ_WOUT == WS_WGU &&
              WS_WGU + 4 * SZ_WGU == WS_WDN && WS_WDN + 4 * SZ_WDN == WS_H && WS_H + (size_t)M * DM * 2 == WS_PROJ && WS_PROJ + (size_t)M * INC * 2 == WS_ANA && WS_T + (size_t)M * DM * 2 == WS_G8 && WS_G8 + (size_t)3 * M * DM == WS_WG8 && WS_WG8 + 4 * SZ_WG8 == WS_XB8 && WS_XB8 + (size_t)M * DM == WS_WGU8 && WS_WGU8 + 4 * SZ_WGU8 == WS_WBR8 && SZ_WGU8 == (size_t)NGU * DM, "d_ws map");
constexpr int CW_TMO = 0;
constexpr int CW_BAR = 4096;
constexpr int CW_AMAX = 65536;
constexpr int CW_AMAXF = 65536 + 4 * NI8;
constexpr int CW_CNT = 16384;
static_assert((CW_CNT + 8 * 64 * 64) <= CW_AMAX && CW_AMAX + 4 * NI8 <= CW_AMAXF && (CW_AMAXF + 4 * 11264) * 4 <= (int)CTL_ZERO_BYTES, "CTL words inside the memset region");
constexpr int RING_OFF = 0, RING_BYTES = 131072;
constexpr int LDSCTL_OFF = RING_BYTES, MISC_OFF = LDSCTL_OFF + 320;
constexpr int RSTD_OFF = LDSCTL_OFF + 1024;
constexpr int XT_OFF = RSTD_OFF + 8192;
constexpr int LDS_BYTES = 151552;
static_assert(XT_OFF + 8192 <= LDS_BYTES, "LDS map");
static_assert(att::SHM_ATTN <= RING_BYTES, "attention LDS fits the ring region");

#define GAS __attribute__((address_space(1)))
#define LAS __attribute__((address_space(3)))
typedef unsigned short bf16;
typedef unsigned v4u __attribute__((ext_vector_type(4)));
typedef unsigned v2u __attribute__((ext_vector_type(2)));
typedef float f32x4 __attribute__((ext_vector_type(4)));
typedef GAS unsigned gu32;
#define RLX_AGENT __ATOMIC_RELAXED, __HIP_MEMORY_SCOPE_AGENT
#define LDS_WAIT() asm volatile("s_waitcnt lgkmcnt(0)" ::: "memory")
#define VM_WAIT() asm volatile("s_waitcnt vmcnt(0)" ::: "memory")
__device__ __forceinline__ unsigned f2bf(float f) { unsigned u = __builtin_bit_cast(unsigned, f); return (u + 0x7fffu + ((u >> 16) & 1u)) >> 16; }
__device__ __forceinline__ unsigned pk2(float lo, float hi) { return f2bf(lo) | (f2bf(hi) << 16); }
__device__ __forceinline__ float bflo(unsigned w) { return __uint_as_float(w << 16); }
__device__ __forceinline__ float bfhi(unsigned w) { return __uint_as_float(w & 0xffff0000u); }
#define XB_TMO      128
#define XB_XCNT(j)  (256  + 64 * (j))
#define XB_XSUB(j)  (1280 + 64 * (j))
#define XB_XGEN(j)  (2304 + 64 * (j))
#define XB_TOP      3328
#define XB_TOPGEN   3392
#define XCD_BAR_WORDS 3456
#define XB_SPIN_CAP (1u << 18)

__device__ __forceinline__ unsigned xb_ld(unsigned* p)              { return __hip_atomic_load(p, __ATOMIC_RELAXED, __HIP_MEMORY_SCOPE_AGENT); }
__device__ __forceinline__ unsigned xb_add(unsigned* p, unsigned v) { return __hip_atomic_fetch_add(p, v, __ATOMIC_RELAXED, __HIP_MEMORY_SCOPE_AGENT); }
__device__ __forceinline__ unsigned xb_xcc_id() { return (unsigned)__builtin_amdgcn_s_getreg((3 << 11) | 20) & 0xFu; }
#define XB_SPIN(cond, bar) do { unsigned _sp = 0; while (cond) { __builtin_amdgcn_s_sleep(1); \
    if ((++_sp & 255u) == 0u) { if (xb_ld(&(bar)[XB_TMO])) break; if (_sp > XB_SPIN_CAP) { atomicAdd(&(bar)[XB_TMO], 1u); break; } } } } while (0)

struct XcdBarrier {
    unsigned* bar; unsigned x;
    volatile LAS unsigned* st;
};

__device__ __forceinline__ XcdBarrier xcd_barrier_post(unsigned* bar, volatile LAS unsigned* st, const bool t0  ) {
    XcdBarrier b; b.bar = bar; b.x = xb_xcc_id(); b.st = st;
    if (t0) (void)xb_add(&bar[XB_XCNT(b.x)], 1u);
    return b;
}
__device__ __forceinline__ void xcd_barrier_complete(unsigned* bar, unsigned x, unsigned& nloc, unsigned& nx) {
    const unsigned G = gridDim.x * gridDim.y * gridDim.z;
    unsigned sum, cnt, mine, sp = 0u;
    for (;;) {
        sum = 0u; cnt = 0u; mine = 0u;
#pragma unroll
        for (unsigned j = 0; j < 16; ++j) { const unsigned c = xb_ld(&bar[XB_XCNT(j)]); sum += c; cnt += (c > 0u) ? 1u : 0u; mine = (j == x) ? c : mine; }
        if (sum == G) break;
        __builtin_amdgcn_s_sleep(1);
        if ((++sp & 255u) == 0u) { if (xb_ld(&bar[XB_TMO])) break; if (sp > XB_SPIN_CAP) { atomicAdd(&bar[XB_TMO], 1u); break; } }
    }
    nloc = mine > 0u ? mine : 1u; nx = cnt > 0u ? cnt : 1u;
}

__device__ __forceinline__ void xcd_barrier(const XcdBarrier& b, const bool t0) {
    asm volatile("s_waitcnt vmcnt(0)" ::: "memory");
    __syncthreads();
    if (t0) {
        unsigned* bar = b.bar;
        __builtin_amdgcn_s_waitcnt(0);
        unsigned nloc = b.st[0], nx = b.st[1];
        if (nloc == 0u) { xcd_barrier_complete(bar, b.x, nloc, nx); b.st[0] = nloc; b.st[1] = nx; }
        const unsigned old = xb_add(&bar[XB_XSUB(b.x)], 1u);
        const unsigned gen = old / nloc;
        if (old + 1u == (gen + 1u) * nloc) {
            __builtin_amdgcn_fence(__ATOMIC_RELEASE, "agent");
            asm volatile("s_waitcnt vmcnt(0)" ::: "memory");
            const unsigned og = xb_add(&bar[XB_TOP], 1u);
            const unsigned tg = og / nx;
            if (og + 1u == (tg + 1u) * nx) xb_add(&bar[XB_TOPGEN], 1u);
            else XB_SPIN(xb_ld(&bar[XB_TOPGEN]) == tg, bar);
            __builtin_amdgcn_fence(__ATOMIC_ACQUIRE, "agent");
            xb_add(&bar[XB_XGEN(b.x)], 1u);
            asm volatile("s_waitcnt vmcnt(0)" ::: "memory");
        } else {
            XB_SPIN(xb_ld(&bar[XB_XGEN(b.x)]) == gen, bar);
            __builtin_amdgcn_fence(__ATOMIC_ACQUIRE, "agent");
            asm volatile("s_waitcnt vmcnt(0)" ::: "memory");
        }
    }
    __syncthreads();
}
#ifndef NT_LOADS
#define NT_LOADS 1
#endif
#if NT_LOADS
#define NTLD(p) __builtin_nontemporal_load(p)
#else
#define NTLD(p) (*(p))
#endif
struct Frame {
    LAS unsigned char* lds;
    volatile LAS unsigned* MISC;
    gu32* ctl;
    int wave;
    int vcu, G;
    unsigned char* ws;
};
#define FTID (F.wave * 64 + lane_id())
#define FLANE (lane_id())
__device__ __forceinline__ float wave_sum(float v, int lane) {
#pragma unroll
    for (int o = 1; o < 64; o <<= 1) v += shfl_xor_l(v, o, lane);
    return v;
}

#ifndef Q8_CLIP
#define Q8_CLIP 0.0f
#endif
__device__ __forceinline__ unsigned q8(float v) { return (unsigned)(int)__builtin_rintf(fminf(fmaxf(v, -127.0f), 127.0f)) & 0xffu; }
__device__ __forceinline__ void transpose_item(const float* __restrict__ W, int ldk, int N, bf16* __restrict__ WT, LAS float* scr, int k0, int kd0, int n0, int drow, int rstride, int lane, const float* __restrict__ gk, unsigned* __restrict__ camax = nullptr  ) {
#ifndef TR_UNROLL
#define TR_UNROLL 16
#endif
#pragma unroll TR_UNROLL
    for (int i = 0; i < 32; ++i) { const int kk = 2 * i + (lane >> 5); scr[kk * 33 + (lane & 31)] = NTLD(&W[(size_t)(k0 + kk) * N + n0 + (lane & 31)]); }
    LDS_WAIT(); asm volatile("" ::: "memory");
    const int c = lane & 7;
    f32x4 ga = (f32x4){1.f, 1.f, 1.f, 1.f}, gb = ga; if (gk) { ga = *(const f32x4*)(gk + k0 + 8 * c); gb = *(const f32x4*)(gk + k0 + 8 * c + 4); }
#pragma unroll
    for (int j = 0; j < 4; ++j) { const int n = (lane >> 3) + 8 * j; const LAS float* s = scr + (8 * c) * 33 + n;
        v4u o; o.x = pk2(s[0 * 33] * ga.x, s[1 * 33] * ga.y); o.y = pk2(s[2 * 33] * ga.z, s[3 * 33] * ga.w); o.z = pk2(s[4 * 33] * gb.x, s[5 * 33] * gb.y); o.w = pk2(s[6 * 33] * gb.z, s[7 * 33] * gb.w);
        *(GAS v4u*)(WT + (size_t)(drow + n * rstride) * ldk + kd0 + 8 * c) = o;
        if (camax) { float m = fmaxf(fmaxf(fmaxf(fabsf(s[0 * 33] * ga.x), fabsf(s[1 * 33] * ga.y)), fmaxf(fabsf(s[2 * 33] * ga.z), fabsf(s[3 * 33] * ga.w))), fmaxf(fmaxf(fabsf(s[4 * 33] * gb.x), fabsf(s[5 * 33] * gb.y)), fmaxf(fabsf(s[6 * 33] * gb.z), fabsf(s[7 * 33] * gb.w))));
            m = fmaxf(m, shfl_xor_l(m, 1, lane)); m = fmaxf(m, shfl_xor_l(m, 2, lane)); m = fmaxf(m, shfl_xor_l(m, 4, lane));
            if (c == 0) atomicMax(camax + n * rstride, __float_as_uint(m)); } }
    LDS_WAIT(); asm volatile("" ::: "memory");
}
__device__ __forceinline__ void gate_item(const float* __restrict__ W, int N, LAS float* scr, int k0, int n0, int gcol0, int lane, const float* __restrict__ gk, unsigned* __restrict__ camax, unsigned char* __restrict__ W8, float* __restrict__ wsc, const int pass) {
#pragma unroll 8
    for (int i = 0; i < 32; ++i) { const int kk = 2 * i + (lane >> 5); scr[kk * 33 + (lane & 31)] = W[(size_t)(k0 + kk) * N + n0 + (lane & 31)]; }
    LDS_WAIT(); asm volatile("" ::: "memory");
    const int c = lane & 7;
    const f32x4 ga = *(const f32x4*)(gk + k0 + 8 * c), gb = *(const f32x4*)(gk + k0 + 8 * c + 4);
#pragma unroll
    for (int j = 0; j < 4; ++j) { const int n = (lane >> 3) + 8 * j; const LAS float* s = scr + (8 * c) * 33 + n;
        const float v0 = s[0 * 33] * ga.x, v1 = s[1 * 33] * ga.y, v2 = s[2 * 33] * ga.z, v3 = s[3 * 33] * ga.w, v4 = s[4 * 33] * gb.x, v5 = s[5 * 33] * gb.y, v6 = s[6 * 33] * gb.z, v7 = s[7 * 33] * gb.w;
        if (pass == 1) { float m = fmaxf(fmaxf(fmaxf(fabsf(v0), fabsf(v1)), fmaxf(fabsf(v2), fabsf(v3))), fmaxf(fmaxf(fabsf(v4), fabsf(v5)), fmaxf(fabsf(v6), fabsf(v7))));
            m = fmaxf(m, shfl_xor_l(m, 1, lane)); m = fmaxf(m, shfl_xor_l(m, 2, lane)); m = fmaxf(m, shfl_xor_l(m, 4, lane));
            if (c == 0) atomicMax(camax + gcol0 + n, __float_as_uint(m)); }
        else { const float am = fmaxf(__uint_as_float(__hip_atomic_load(camax + gcol0 + n, RLX_AGENT)), 1e-30f), inv = 127.0f / am;
            v2u o; o.x = q8(v0 * inv) | (q8(v1 * inv) << 8) | (q8(v2 * inv) << 16) | (q8(v3 * inv) << 24); o.y = q8(v4 * inv) | (q8(v5 * inv) << 8) | (q8(v6 * inv) << 16) | (q8(v7 * inv) << 24);
            *(GAS v2u*)(W8 + (size_t)(gcol0 + n) * DM + k0 + 8 * c) = o;
            if (k0 == 0 && c == 0) wsc[gcol0 + n] = am * (1.0f / 127.0f); } }
    LDS_WAIT(); asm volatile("" ::: "memory");
}
__device__ __forceinline__ void i8_item(const float* __restrict__ W, const int N, const int n0, const float* __restrict__ gk, unsigned char* __restrict__ W8, float* __restrict__ wsc, const int drow, const int rstride, LAS unsigned char* lds, const int wave, const int lane) {
    LAS unsigned* st = (LAS unsigned*)lds; LAS float* amx = (LAS float*)(lds + 32 * 513 * 4);
    const int n = lane & 31, h = lane >> 5, kb = h * 1024 + wave * 128;
    const GAS float* wp = (const GAS float*)W + (size_t)kb * N + n0 + n;
    const float* gq0 = gk + wave * 128; const float* gq1 = gk + 1024 + wave * 128;
    unsigned pk[64]; float am = 0.f;
    float wa[32], wb[32];
#define I8_LOAD(dst, bt) do { _Pragma("unroll") for (int i_ = 0; i_ < 32; ++i_) dst[i_] = NTLD(&wp[(size_t)(32 * (bt) + i_) * N]); } while (0)
#define I8_USE(src, bt) do { _Pragma("unroll") for (int i_ = 0; i_ < 16; ++i_) { const int k_ = 32 * (bt) + 2 * i_; \
        const float v0_ = src[2 * i_] * (h ? gq1[k_] : gq0[k_]), v1_ = src[2 * i_ + 1] * (h ? gq1[k_ + 1] : gq0[k_ + 1]); const unsigned b_ = pk2(v0_, v1_); pk[16 * (bt) + i_] = b_; \
        am = fmaxf(am, fmaxf(fabsf(bflo(b_)), fabsf(bfhi(b_)))); } } while (0)
    I8_LOAD(wa, 0); __builtin_amdgcn_sched_barrier(0);
    I8_LOAD(wb, 1); __builtin_amdgcn_sched_barrier(0);
    I8_USE(wa, 0); __builtin_amdgcn_sched_barrier(0);
    I8_LOAD(wa, 2); __builtin_amdgcn_sched_barrier(0);
    I8_USE(wb, 1); __builtin_amdgcn_sched_barrier(0);
    I8_LOAD(wb, 3); __builtin_amdgcn_sched_barrier(0);
    I8_USE(wa, 2); __builtin_amdgcn_sched_barrier(0);
    I8_USE(wb, 3); __builtin_amdgcn_sched_barrier(0);
#undef I8_LOAD
#undef I8_USE
    amx[(wave * 2 + h) * 32 + n] = am;
    __syncthreads();
    float cm = amx[n];
#pragma unroll
    for (int q = 1; q < 16; ++q) cm = fmaxf(cm, amx[q * 32 + n]);
    cm = fmaxf(cm, 1e-30f); const float inv = 127.0f / cm;
#pragma unroll
    for (int j = 0; j < 32; ++j) { const unsigned a_ = pk[2 * j], b_ = pk[2 * j + 1];
        st[n * 513 + (kb >> 2) + j] = q8(bflo(a_) * inv) | (q8(bfhi(a_) * inv) << 8) | (q8(bflo(b_) * inv) << 16) | (q8(bfhi(b_) * inv) << 24); }
    __syncthreads();
    const int tid = wave * 64 + lane;
#pragma unroll 4
    for (int idx = tid; idx < 32 * 512; idx += NWAVES * 64) { const int r = idx >> 9, d = idx & 511; ((GAS unsigned*)(W8 + (size_t)(drow + r * rstride) * DM))[d] = st[r * 513 + d]; }
    if (tid < 32) wsc[drow + tid * rstride] = cm * (1.0f / 127.0f);
    __syncthreads();
}
__device__ __forceinline__ float wave_max(float v, int lane) {
#pragma unroll
    for (int o = 1; o < 64; o <<= 1) v = fmaxf(v, shfl_xor_l(v, o, lane));
    return v;
}
__device__ __forceinline__ void xb_row(const float* __restrict__ xrow, bf16* __restrict__ hrow, float* __restrict__ ssx, unsigned char* __restrict__ x8row, float* __restrict__ asc, int lane) {
    const GAS f32x4* xr = (const GAS f32x4*)xrow + lane; GAS v2u* o8 = (GAS v2u*)hrow + lane; float s = 0.f, am = 0.f; f32x4 v[8];
#pragma unroll
    for (int j = 0; j < 8; ++j) { v[j] = xr[64 * j]; s += (v[j].x * v[j].x + v[j].y * v[j].y) + (v[j].z * v[j].z + v[j].w * v[j].w); am = fmaxf(fmaxf(am, fmaxf(fabsf(v[j].x), fabsf(v[j].y))), fmaxf(fabsf(v[j].z), fabsf(v[j].w)));
        v2u w; w.x = pk2(v[j].x, v[j].y); w.y = pk2(v[j].z, v[j].w); o8[64 * j] = w; }
    s = wave_sum(s, lane); am = fmaxf(wave_max(am, lane), 1e-30f); if (Q8_CLIP > 0.f) am = fminf(am, Q8_CLIP * __builtin_sqrtf(s * (1.0f / DM)));
    const float inv = 127.0f / am;
#pragma unroll
    for (int j = 0; j < 8; ++j) ((GAS unsigned*)x8row + lane)[64 * j] = q8(v[j].x * inv) | (q8(v[j].y * inv) << 8) | (q8(v[j].z * inv) << 16) | (q8(v[j].w * inv) << 24);
    if (lane == 0) { *ssx = s; *asc = am * (1.0f / 127.0f); }
}
template <bool XF32, bool FOUT, bool Q8, int R>
__device__ __forceinline__ void post_rows_bf(const bf16* __restrict__ T, const float* __restrict__ xf, const bf16* XBp, const float* __restrict__ gpost, float* __restrict__ ssx, float* __restrict__ fout, unsigned char* __restrict__ X8, float* __restrict__ asc, const int (&rows)[R], int lane, bf16* XBo) {
    v4u tw[R][4]; v4u xw[R][4]; f32x4 xa[R][4], xb2[R][4];
#pragma unroll
    for (int r = 0; r < R; ++r)
#pragma unroll
        for (int j = 0; j < 4; ++j) { const size_t e = (size_t)rows[r] * DM + 8 * (64 * j + lane);
            tw[r][j] = NTLD((const GAS v4u*)(T + e));
            if constexpr (XF32) { xa[r][j] = NTLD((const GAS f32x4*)(xf + e)); xb2[r][j] = NTLD((const GAS f32x4*)(xf + e + 4)); } else xw[r][j] = NTLD((const GAS v4u*)(XBp + e)); }
    f32x4 g0[4], g1[4];
#pragma unroll
    for (int j = 0; j < 4; ++j) { g0[j] = *(const GAS f32x4*)(gpost + 8 * (64 * j + lane)); g1[j] = *(const GAS f32x4*)(gpost + 8 * (64 * j + lane) + 4); }
    float s[R];
#pragma unroll
    for (int r = 0; r < R; ++r) { float a = 0.f;
#pragma unroll
        for (int j = 0; j < 4; ++j) { const v4u w = tw[r][j]; const float t0 = bflo(w.x), t1 = bfhi(w.x), t2 = bflo(w.y), t3 = bfhi(w.y), t4 = bflo(w.z), t5 = bfhi(w.z), t6 = bflo(w.w), t7 = bfhi(w.w);
            a += ((t0 * t0 + t1 * t1) + (t2 * t2 + t3 * t3)) + ((t4 * t4 + t5 * t5) + (t6 * t6 + t7 * t7)); }
        s[r] = a; }
#pragma unroll
    for (int o = 1; o < 64; o <<= 1)
#pragma unroll
        for (int r = 0; r < R; ++r) s[r] += shfl_xor_l(s[r], o, lane);
#pragma unroll
    for (int r = 0; r < R; ++r) { const float rstd = __builtin_amdgcn_rsqf(s[r] * (1.f / DM) + RMS_EPS); float s2 = 0.f, am = 0.f;
#pragma unroll
        for (int j = 0; j < 4; ++j) { const v4u w = tw[r][j]; f32x4 xl, xh;
            if constexpr (XF32) { xl = xa[r][j]; xh = xb2[r][j]; } else { const v4u q = xw[r][j]; xl = (f32x4){bflo(q.x), bfhi(q.x), bflo(q.y), bfhi(q.y)}; xh = (f32x4){bflo(q.z), bfhi(q.z), bflo(q.w), bfhi(q.w)}; }
            xl = xl + (f32x4){bflo(w.x), bfhi(w.x), bflo(w.y), bfhi(w.y)} * rstd * g0[j]; xh = xh + (f32x4){bflo(w.z), bfhi(w.z), bflo(w.w), bfhi(w.w)} * rstd * g1[j];
            const size_t e = (size_t)rows[r] * DM + 8 * (64 * j + lane);
            if constexpr (FOUT) { *(GAS f32x4*)(fout + e) = xl; *(GAS f32x4*)(fout + e + 4) = xh; }
            else { v4u o; o.x = pk2(xl.x, xl.y); o.y = pk2(xl.z, xl.w); o.z = pk2(xh.x, xh.y); o.w = pk2(xh.z, xh.w); *(GAS v4u*)(XBo + e) = o; }
            s2 += ((xl.x * xl.x + xl.y * xl.y) + (xl.z * xl.z + xl.w * xl.w)) + ((xh.x * xh.x + xh.y * xh.y) + (xh.z * xh.z + xh.w * xh.w));
            if constexpr (Q8) am = fmaxf(fmaxf(fmaxf(am, fmaxf(fabsf(xl.x), fabsf(xl.y))), fmaxf(fabsf(xl.z), fabsf(xl.w))), fmaxf(fmaxf(fabsf(xh.x), fabsf(xh.y)), fmaxf(fabsf(xh.z), fabsf(xh.w)))); }
        if constexpr (!FOUT) { s2 = wave_sum(s2, lane); if (lane == 0) ssx[rows[r]] = s2; }
        if constexpr (Q8) {
            am = fmaxf(wave_max(am, lane), 1e-30f); if (Q8_CLIP > 0.f) am = fminf(am, Q8_CLIP * __builtin_sqrtf(s2 * (1.0f / DM)));
            const float inv = 127.0f / am; if (lane == 0) asc[rows[r]] = am * (1.0f / 127.0f);
#pragma unroll
            for (int j = 0; j < 4; ++j) { const v4u w = tw[r][j]; f32x4 xl, xh;
                if constexpr (XF32) { xl = xa[r][j]; xh = xb2[r][j]; } else { const v4u q = xw[r][j]; xl = (f32x4){bflo(q.x), bfhi(q.x), bflo(q.y), bfhi(q.y)}; xh = (f32x4){bflo(q.z), bfhi(q.z), bflo(q.w), bfhi(q.w)}; }
                xl = xl + (f32x4){bflo(w.x), bfhi(w.x), bflo(w.y), bfhi(w.y)} * rstd * g0[j]; xh = xh + (f32x4){bflo(w.z), bfhi(w.z), bflo(w.w), bfhi(w.w)} * rstd * g1[j];
                v2u o; o.x = q8(xl.x * inv) | (q8(xl.y * inv) << 8) | (q8(xl.z * inv) << 16) | (q8(xl.w * inv) << 24); o.y = q8(xh.x * inv) | (q8(xh.y * inv) << 8) | (q8(xh.z * inv) << 16) | (q8(xh.w * inv) << 24);
                *(GAS v2u*)(X8 + (size_t)rows[r] * DM + 8 * (64 * j + lane)) = o; } } }
}
__device__ __forceinline__ void conv_rows(Frame& F, const bf16* __restrict__ proj, const float* __restrict__ cw, const float* __restrict__ cb, bf16* __restrict__ acv, const int apitch  ) {
    int ln = FLANE; asm volatile("" : "+v"(ln));
    const int gw = F.vcu * NWAVES + F.wave, NGW = F.G * NWAVES; const int c0 = ln * 16;
    float w0[16], w1[16], w2[16], bb[16];
#pragma unroll
    for (int e = 0; e < 16; ++e) { w0[e] = cw[c0 + e]; w1[e] = cw[1024 + c0 + e]; w2[e] = cw[2048 + c0 + e]; bb[e] = cb[c0 + e]; }
#define CONV_U(dst, mrow) do { const v4u* ph_ = (const v4u*)(proj + (size_t)(mrow) * INC + C_CH + c0); const v4u* pc_ = (const v4u*)(proj + (size_t)(mrow) * INC + C_CC + c0); \
        const v4u h0_ = ph_[0], h1_ = ph_[1], g0_ = pc_[0], g1_ = pc_[1]; \
        dst[0] = bflo(h0_.x) * bflo(g0_.x); dst[1] = bfhi(h0_.x) * bfhi(g0_.x); dst[2] = bflo(h0_.y) * bflo(g0_.y); dst[3] = bfhi(h0_.y) * bfhi(g0_.y); \
        dst[4] = bflo(h0_.z) * bflo(g0_.z); dst[5] = bfhi(h0_.z) * bfhi(g0_.z); dst[6] = bflo(h0_.w) * bflo(g0_.w); dst[7] = bfhi(h0_.w) * bfhi(g0_.w); \
        dst[8] = bflo(h1_.x) * bflo(g1_.x); dst[9] = bfhi(h1_.x) * bfhi(g1_.x); dst[10] = bflo(h1_.y) * bflo(g1_.y); dst[11] = bfhi(h1_.y) * bfhi(g1_.y); \
        dst[12] = bflo(h1_.z) * bflo(g1_.z); dst[13] = bfhi(h1_.z) * bfhi(g1_.z); dst[14] = bflo(h1_.w) * bflo(g1_.w); dst[15] = bfhi(h1_.w) * bfhi(g1_.w); } while (0)
    for (int m0 = gw * 8; m0 < M; m0 += NGW * 8) {
        float up[16], uc[16], un[16];
        if ((m0 & (SEQ - 1)) == 0) {
#pragma unroll
            for (int e = 0; e < 16; ++e) up[e] = 0.f;
        } else CONV_U(up, m0 - 1);
        CONV_U(uc, m0);
        for (int r = 0; r < 8; ++r) { const int m = m0 + r;
            if ((m & (SEQ - 1)) == SEQ - 1) {
#pragma unroll
                for (int e = 0; e < 16; ++e) un[e] = 0.f;
            } else CONV_U(un, m + 1);
            const v4u* pb = (const v4u*)(proj + (size_t)m * INC + C_CB + c0); const v4u b0 = pb[0], b1 = pb[1];
            const float bg[16] = {bflo(b0.x), bfhi(b0.x), bflo(b0.y), bfhi(b0.y), bflo(b0.z), bfhi(b0.z), bflo(b0.w), bfhi(b0.w), bflo(b1.x), bfhi(b1.x), bflo(b1.y), bfhi(b1.y), bflo(b1.z), bfhi(b1.z), bflo(b1.w), bfhi(b1.w)};
            float y[16];
#pragma unroll
            for (int e = 0; e < 16; ++e) y[e] = bg[e] * (bb[e] + w0[e] * up[e] + w1[e] * uc[e] + w2[e] * un[e]);
            v4u o0, o1; o0.x = pk2(y[0], y[1]); o0.y = pk2(y[2], y[3]); o0.z = pk2(y[4], y[5]); o0.w = pk2(y[6], y[7]); o1.x = pk2(y[8], y[9]); o1.y = pk2(y[10], y[11]); o1.z = pk2(y[12], y[13]); o1.w = pk2(y[14], y[15]);
            v4u* po = (v4u*)(acv + (size_t)m * apitch + c0); po[0] = o0; po[1] = o1;
#pragma unroll
            for (int e = 0; e < 16; ++e) { up[e] = uc[e]; uc[e] = un[e]; }
        }
    }
#undef CONV_U
}

#ifndef REP_P0
#define REP_P0 1
#endif
#ifndef REP_P1
#define REP_P1 1
#endif
#ifndef REP_P3
#define REP_P3 1
#endif
#ifndef REP_P4
#define REP_P4 1
#endif
#ifndef REP_P5
#define REP_P5 1
#endif
#ifndef REP_P7
#define REP_P7 1
#endif
#ifndef REP_P8
#define REP_P8 1
#endif
#ifndef GQA_K8
#define GQA_K8 1
#endif
#ifndef GQA_V8
#define GQA_V8 1
#endif
#ifndef BR8
#define BR8 1
#endif
#ifndef BR8_MIX
#define BR8_MIX 16
#endif
#ifndef NA_K8
#define NA_K8 0
#endif
#ifndef GQA_SDEPTH_FIXED
#define GQA_SDEPTH_FIXED 1
#endif
#ifndef GQA_SDEPTH
#define GQA_SDEPTH 1
#endif
struct Args { const float* in[18]; float* out; unsigned char* ws; };
typedef const __attribute__((address_space(4))) Args* KArgP;
__device__ __forceinline__ KArgP kargs() { KArgP p = (KArgP)__builtin_amdgcn_kernarg_segment_ptr(); asm volatile("" : "+s"(p)); return p; }
#define AIN(k) (kargs()->in[k])
__global__ void __launch_bounds__(NWAVES * 64, 2) mega_fwd(Args args) {
    extern __shared__ __attribute__((aligned(16))) unsigned char lds[];
    Frame F;
    F.lds = (LAS unsigned char*)lds;
    F.MISC = (volatile LAS unsigned*)(F.lds + MISC_OFF);
    F.wave = __builtin_amdgcn_readfirstlane((int)threadIdx.x >> 6);

    F.G = gridDim.x; { const int bx = blockIdx.x; F.vcu = (F.G % 8 == 0) ? (bx % 8) * (F.G / 8) + bx / 8 : bx; }
    F.ws = args.ws; F.ctl = (gu32*)(args.ws + WS_CTL);
#define ws (kargs()->ws)
#define x_in AIN(0)
#define out (kargs()->out)
#define Hb ((bf16*)(ws + WS_H))
#define PROJ ((bf16*)(ws + WS_PROJ))
#define ACT ((bf16*)(ws + WS_ACT))
#define ABR ((bf16*)(ws + WS_ANA))
#define MRG ((bf16*)(ws + WS_MRG))
#define SSX ((float*)(ws + WS_SSX))
#define XB8 ((unsigned char*)(ws + WS_XB8))
#define ASC ((float*)(ws + WS_ASC))
#define WSC ((float*)(ws + WS_WSC))
#define WSCF ((float*)(ws + WS_WSCF))
#define Tb ((bf16*)(ws + WS_T))
#define KC ((bf16*)(ws + WS_T))
#define VC ((bf16*)(ws + WS_T + 8 * MiB))
#define KC8 ((unsigned char*)(ws + WS_T + 16 * MiB))
#define KN8 ((unsigned char*)(ws + WS_T + 20 * MiB))
#define VT8 ((unsigned char*)(ws + WS_T + 36 * MiB))
#define rope ((float*)(ws + WS_ROPE))
    for (int u = FTID; u < (LDS_BYTES - LDSCTL_OFF) / 4; u += NWAVES * 64) ((LAS unsigned*)(F.lds + LDSCTL_OFF))[u] = 0u;
    __syncthreads();
    XcdBarrier bar = xcd_barrier_post((unsigned*)(F.ctl + CW_BAR), F.MISC + 8, FTID == 0);
#ifndef REP_BAR
#define REP_BAR 1
#endif
#define GRID_BAR() do { for (int rb_ = 0; rb_ < REP_BAR; ++rb_) xcd_barrier(bar, FTID == 0); } while (0)
    const int gw = F.vcu * NWAVES + F.wave, NGW = F.G * NWAVES;
#ifdef PROBE_TS
#define TS_B(id) do { if ((id) == PROBE_TS && l == PROBE_TS_L && blockIdx.x == 0 && FTID == 0) F.MISC[16] = (unsigned)__builtin_amdgcn_s_memrealtime(); } while (0)
#define TS_E(id) do { if ((id) == PROBE_TS && l == PROBE_TS_L && blockIdx.x == 0 && FTID == 0) F.MISC[17] = (unsigned)__builtin_amdgcn_s_memrealtime() - F.MISC[16]; } while (0)
#else
#define TS_B(id) do {} while (0)
#define TS_E(id) do {} while (0)
#endif

    for (int rep_ = 0; rep_ < REP_P0; ++rep_) {
    {
        LAS float* scr = (LAS float*)(F.lds + RING_OFF + F.wave * 16384);
        constexpr int NCONV = C_GNA - C_CH;
        constexpr int I_IN = (DM / 64) * (NCONV / 32), I_BR = (1024 / 64) * (DM / 32), I_OUT = (DM / 64) * (DM / 32), I_D = (FF / 64) * (DM / 32);
        constexpr int I_LAYER = I_IN + 3 * I_BR + I_OUT + I_D;
#ifndef NO_TRANS
#ifndef REP_TR
#define REP_TR 1
#endif
        for (int rt_ = 0; rt_ < REP_TR; ++rt_)
        for (int it = gw; it < DEPTH * I_LAYER; it += NGW) {
            const int l = it / I_LAYER; int r = it - l * I_LAYER;
            const float* W; bf16* WT; const float* gk = nullptr; int K, N, koff = 0, nofs = 0;
            if (r < I_IN) { W = AIN(1) + (size_t)l * DM * INC; WT = (bf16*)(ws + WS_WIN + l * SZ_WIN); K = DM; N = INC; gk = AIN(11) + l * DM; nofs = C_CH; }
            else if ((r -= I_IN) < 3 * I_BR) { const int br = r / I_BR; r -= br * I_BR; W = AIN(7 + br) + (size_t)l * 1024 * DM; WT = (bf16*)(ws + WS_WBR + (size_t)l * 3 * SZ_WBR); K = 3072; N = DM; koff = br * 1024; }
            else if ((r -= 3 * I_BR) < I_OUT) { W = AIN(10) + (size_t)l * DM * DM; WT = (bf16*)(ws + WS_WOUT + l * SZ_WOUT); K = DM; N = DM; }
            else { r -= I_OUT; W = AIN(17) + (size_t)l * FF * DM; WT = (bf16*)(ws + WS_WDN + l * SZ_WDN); K = FF; N = DM; }
            const int nblk = (nofs ? NCONV : N) / 32, kb = r / nblk, nb = r - kb * nblk, n0 = nofs + 32 * nb;
            transpose_item(W, K, N, WT, scr, 64 * kb, koff + 64 * kb, n0, n0, 1, FLANE, gk, nullptr);
        }
#endif
        __syncthreads();
        {
            constexpr int J_IN = NI8 / 32, J_G = FF / 32, J_LAYER = J_IN + 2 * J_G;
            int ln_ = FLANE; asm volatile("" : "+v"(ln_));
#ifndef REP_I8
#define REP_I8 1
#endif
            for (int ri_ = 0; ri_ < REP_I8; ++ri_)
            for (int it = F.vcu; it < DEPTH * J_LAYER; it += F.G) {
                const int l = it / J_LAYER; int r = it - l * J_LAYER;
                if (r < J_IN) {
                    const int n0 = r < NQKV / 32 ? 32 * r : C_GNA + 32 * (r - NQKV / 32); int drow = n0, rstride = 1;
                    if (n0 >= C_GQ && n0 < C_GV) { const int B_ = (n0 & 127) >> 5; drow = (n0 & ~127) + 64 * (B_ >> 1) + (B_ & 1); rstride = 2; }
                    const int r8 = drow < C_CH ? drow : drow - C_GNA + NQKV;
                    i8_item(AIN(1) + (size_t)l * DM * INC, INC, n0, AIN(11) + l * DM, (unsigned char*)(ws + WS_WG8 + l * SZ_WG8), WSC + l * NI8, r8, rstride, F.lds + RING_OFF, F.wave, ln_);
                } else { r -= J_IN; const int up = r / J_G, n0 = 32 * (r - up * J_G), drow = (n0 >> 7) * 256 + up * 128 + (n0 & 127);
                    i8_item(AIN(15 + up) + (size_t)l * DM * FF, FF, n0, AIN(13) + l * DM, (unsigned char*)(ws + WS_WGU8 + l * SZ_WGU8), WSCF + l * NGU, drow, 1, F.lds + RING_OFF, F.wave, ln_); }
            }
        }
#if BR8
        GRID_BAR();
        {
            const int ln3 = FLANE;
            for (int row = gw; row < DEPTH * DM; row += NGW) {
                const int l3 = row >> 11, n3 = row & (DM - 1);
                const bf16* src = (const bf16*)(ws + WS_WBR + (size_t)l3 * 3 * SZ_WBR) + (size_t)n3 * 3072; unsigned char* dst = (unsigned char*)(ws + WS_WBR8 + (size_t)l3 * SZ_WBR8) + (size_t)n3 * 4096;
                v4u w[6]; float am = 0.f;
#pragma unroll
                for (int q = 0; q < 6; ++q) { w[q] = *(const GAS v4u*)(src + 8 * (64 * q + ln3));
                    am = fmaxf(am, fmaxf(fmaxf(fmaxf(fabsf(bflo(w[q].x)), fabsf(bfhi(w[q].x))), fmaxf(fabsf(bflo(w[q].y)), fabsf(bfhi(w[q].y)))), fmaxf(fmaxf(fabsf(bflo(w[q].z)), fabsf(bfhi(w[q].z))), fmaxf(fabsf(bflo(w[q].w)), fabsf(bfhi(w[q].w)))))); }
                am = fmaxf(wave_max(am, ln3), 1e-30f);
                const int ex = 134 - (int)((__float_as_uint(am) >> 23) & 0xffu);
                const float p = __uint_as_float((unsigned)(min(max(ex, -100), 100) + 127) << 23);
#pragma unroll
                for (int q = 0; q < 4; ++q) { int w0 = 0, w1 = 0;
                    w0 = __builtin_amdgcn_cvt_pk_fp8_f32(bflo(w[q].x) * p, bfhi(w[q].x) * p, w0, false); w0 = __builtin_amdgcn_cvt_pk_fp8_f32(bflo(w[q].y) * p, bfhi(w[q].y) * p, w0, true);
                    w1 = __builtin_amdgcn_cvt_pk_fp8_f32(bflo(w[q].z) * p, bfhi(w[q].z) * p, w1, false); w1 = __builtin_amdgcn_cvt_pk_fp8_f32(bflo(w[q].w) * p, bfhi(w[q].w) * p, w1, true);
                    v2u o; o.x = (unsigned)w0; o.y = (unsigned)w1; *(GAS v2u*)(dst + 8 * (64 * q + ln3)) = o; }
#pragma unroll
                for (int q = 4; q < 6; ++q) { v4u o; o.x = pk2(bflo(w[q].x) * p, bfhi(w[q].x) * p); o.y = pk2(bflo(w[q].y) * p, bfhi(w[q].y) * p); o.z = pk2(bflo(w[q].z) * p, bfhi(w[q].z) * p); o.w = pk2(bflo(w[q].w) * p, bfhi(w[q].w) * p);
                    *(GAS v4u*)(dst + 2048 + 16 * (64 * (q - 4) + ln3)) = o; }
                if (ln3 == 0) ((float*)(ws + WS_WSB))[row] = 1.0f / p;
            }
        }
#endif
#ifndef NO_ROPE
        for (int e = F.vcu * NWAVES * 64 + FTID; e < 192 * 32; e += F.G * NWAVES * 64) {
            const int pos = e >> 5, i = e & 31; const int p = pos < 128 ? pos : pos - 128;
            const float inv = 1.0f / powf(10000.0f, (float)i * (1.0f / 32.0f));
            const float ang = (float)p * inv;
            rope[2 * e] = cosf(ang); rope[2 * e + 1] = sinf(ang);
        }
#endif

        { int ln = FLANE; asm volatile("" : "+v"(ln)); for (int m = gw; m < M; m += NGW) xb_row(x_in + (size_t)m * DM, Hb + (size_t)m * DM, SSX + m, XB8 + (size_t)m * DM, ASC + m, ln); }
    }
    GRID_BAR();
    }

    for (int l = 0; l < DEPTH; ++l) {
        TS_B(1);
        for (int rep_ = 0; rep_ < REP_P1; ++rep_) {
        {
            pg8::Gemm g{Hb, (const bf16*)(ws + WS_WIN + l * SZ_WIN) + (size_t)C_CH * DM, M, C_GNA - C_CH, DM}; pg8::StaticOrder S; S.init(M, C_GNA - C_CH, F.G, (int)blockIdx.x);
            { LAS float* rt_ = (LAS float*)(F.lds + RSTD_OFF); const int rb_ = ((int)blockIdx.x & 7) * 2048;
              int t0_ = FTID; asm volatile("" : "+v"(t0_));
              for (int r_ = t0_; r_ < 2048; r_ += NWAVES * 64) rt_[r_] = __builtin_amdgcn_rsqf(SSX[rb_ + r_] * (1.0f / DM) + RMS_EPS);
              __syncthreads(); }
            pg8::EpiIn E{PROJ + C_CH, INC, 1 << 20, (const LAS float*)(F.lds + RSTD_OFF), ((int)blockIdx.x & 7) * 2048, -1, -1, KC, VC, AIN(4) + l * HD, rope, (LAS float*)(F.lds + XT_OFF), 13, (unsigned char*)(ws + WS_G8), 1 << 20, KC8, KN8, -1, -1, nullptr};
#ifndef NO_P1
            pg8::gemm_phase<pg8::EpiIn, pg8::StaticOrder, true, true>(F.lds + RING_OFF, g, S, E, F.wave);
#endif
            { LAS float* rt_ = (LAS float*)(F.lds + RSTD_OFF); const int rb_ = ((int)blockIdx.x & 7) * 2048;
              int t0_ = FTID; asm volatile("" : "+v"(t0_));
              for (int r_ = t0_; r_ < 2048; r_ += NWAVES * 64) rt_[r_] = __builtin_amdgcn_rsqf(SSX[rb_ + r_] * (1.0f / DM) + RMS_EPS) * ASC[rb_ + r_];
              __syncthreads(); }
            { pg8::Gemm g8{(const bf16*)XB8, (const bf16*)(ws + WS_WG8 + l * SZ_WG8), M, NI8, DM / 2}; pg8::GateOrder<10, 11> S8{(int)blockIdx.x};
              pg8::EpiInGate8<NQKV / 256> E8{pg8::EpiIn{PROJ, INC, 1 << 20, (const LAS float*)(F.lds + RSTD_OFF), ((int)blockIdx.x & 7) * 2048, C_GK / 256, C_GV / 256, KC, VC, AIN(4) + l * HD, rope, (LAS float*)(F.lds + XT_OFF), 13, (unsigned char*)(ws + WS_G8), 1 << 20, KC8, KN8, NA_K8 ? C_NAK / 256 : -1, NA_K8 ? C_NAV / 256 : -1, GQA_V8 ? VT8 : nullptr},
                                             (unsigned char*)(ws + WS_G8), (size_t)M * DM, WSC + l * NI8};
#ifndef NO_P1
              pg8::gemm_phase<pg8::EpiInGate8<NQKV / 256>, pg8::GateOrder<10, 11>, true, true, true>(F.lds + RING_OFF, g8, S8, E8, F.wave);
#endif
            }

        }
        GRID_BAR();
        }
        TS_E(1);
        TS_B(3);
        for (int rep_ = 0; rep_ < REP_P3; ++rep_) {
        {
#ifndef REP_CONV
#define REP_CONV 1
#endif
            for (int rc_ = 0; rc_ < REP_CONV; ++rc_)
            conv_rows(F, PROJ, AIN(5) + (size_t)l * 3 * 1024, AIN(6) + (size_t)l * 1024, BR8 ? ABR + 1024 : ABR + 2048, BR8 ? 2048 : 3072);
#ifndef NO_GQA
            bool gfix_; { const float* kg_ = AIN(4) + l * HD; const float* qg_ = AIN(3) + l * HD; const int ln_ = lane_id(); float gk_ = fmaxf(fabsf(kg_[ln_]), fabsf(kg_[64 + ln_])), gq_ = fmaxf(fabsf(qg_[ln_]), fabsf(qg_[64 + ln_]));
#pragma unroll
              for (int o_ = 1; o_ < 64; o_ <<= 1) { gk_ = fmaxf(gk_, shfl_xor_l(gk_, o_, ln_)); gq_ = fmaxf(gq_, shfl_xor_l(gq_, o_, ln_)); }
              gfix_ = __builtin_amdgcn_readfirstlane((int)(16.65f * gq_ * gk_ <= 40.0f && gq_ <= 30.0f && gk_ <= 30.0f)) != 0; }
            if (gfix_) {
            for (int i = 0;; ++i) { const int unit = i * F.G + F.vcu; if (unit >= 512) break;
                const int b = unit >> 8, h = (unit >> 5) & 7, qb = unit & 31;
                const size_t tok0 = (size_t)b * SEQ + (size_t)qb * 256;
                att::attn_unit<false, true, GQA_SDEPTH_FIXED, INC, HD, BR8 ? 4096 : 3072, GQA_K8 != 0, 128, BR8 != 0, (GQA_K8 != 0 && GQA_V8 != 0)>(PROJ + tok0 * INC + C_GQ + h * HD, GQA_K8 ? (const bf16*)(KC8 + (size_t)(b * 2 + (h >> 2)) * SEQ * 128) : KC + (size_t)(b * 2 + (h >> 2)) * SEQ * HD, (GQA_K8 && GQA_V8) ? (const bf16*)(VT8 + (size_t)(b * 2 + (h >> 2)) * HD * SEQ) : VC + (size_t)(b * 2 + (h >> 2)) * SEQ * HD,
                                                      BR8 ? (bf16*)((unsigned char*)ABR + tok0 * 4096 + 1024 + h * HD) : ABR + tok0 * 3072 + 1024 + h * HD, SEQ / 64, 0, 0, nullptr, AIN(3) + l * HD, rope, qb * 256, 0.f, (LAS char*)(F.lds + RING_OFF), F.wave); }
            } else {
            for (int i = 0;; ++i) { const int unit = i * F.G + F.vcu; if (unit >= 512) break;
                const int b = unit >> 8, h = (unit >> 5) & 7, qb = unit & 31;
                const size_t tok0 = (size_t)b * SEQ + (size_t)qb * 256;
                att::attn_unit<false, false, GQA_SDEPTH, INC, HD, BR8 ? 4096 : 3072, false, 128, BR8 != 0>(PROJ + tok0 * INC + C_GQ + h * HD, KC + (size_t)(b * 2 + (h >> 2)) * SEQ * HD, VC + (size_t)(b * 2 + (h >> 2)) * SEQ * HD,
                                                      BR8 ? (bf16*)((unsigned char*)ABR + tok0 * 4096 + 1024 + h * HD) : ABR + tok0 * 3072 + 1024 + h * HD, SEQ / 64, 0, 0, nullptr, AIN(3) + l * HD, rope, qb * 256, 0.f, (LAS char*)(F.lds + RING_OFF), F.wave); }
            }
#endif
#ifndef NO_NA
#ifndef REP_NA
#define REP_NA 1
#endif
            for (int rn_ = 0; rn_ < REP_NA; ++rn_)
            for (int i = 0;; ++i) { const int unit = i * F.G + F.vcu; if (unit >= 512) break;
                const int b = unit >> 8, h = (unit >> 5) & 7, rg = unit & 31;
                const size_t tok0 = (size_t)b * SEQ + (size_t)rg * 256; const int r0 = rg * 4, krow0 = min(max(r0 - 4, 0), 120);
                att::attn_unit<true, false, 1, INC, INC, BR8 ? 4096 : 3072, NA_K8 != 0, 1024, BR8 != 0>(PROJ + tok0 * INC + C_NAQ + h * HD, NA_K8 ? (const bf16*)(KN8 + (size_t)b * SEQ * 1024 + h * HD) : PROJ + (size_t)b * SEQ * INC + C_NAK + h * HD, PROJ + (size_t)b * SEQ * INC + C_NAV + h * HD,
                                                     BR8 ? (bf16*)((unsigned char*)ABR + tok0 * 4096 + h * HD) : ABR + tok0 * 3072 + h * HD, 12, krow0, r0, AIN(2) + (size_t)(l * 8 + h) * 15 * 31, nullptr, nullptr, 0, 0.f, (LAS char*)(F.lds + RING_OFF), F.wave); }
#endif
        }
        GRID_BAR();
        }
        TS_E(3);
        TS_B(4);
        for (int rep_ = 0; rep_ < REP_P4; ++rep_) {
        {
            pg8::StaticOrder S; S.init(M, DM, F.G, (int)blockIdx.x);
#if BR8
            pg8::Gemm g{ABR, (const bf16*)(ws + WS_WBR8 + (size_t)l * SZ_WBR8), M, DM, 2048}; pg8::EpiBranchK<8, 16, true> E{MRG, DM, (const unsigned char*)(ws + WS_G8), (size_t)M * DM, (const float*)(ws + WS_WSB) + l * DM};
            pg8::gemm_phase<pg8::EpiBranchK<8, 16, true>, pg8::StaticOrder, true, true, false, BR8_MIX>(F.lds + RING_OFF, g, S, E, F.wave);
#else
            pg8::Gemm g{ABR, (const bf16*)(ws + WS_WBR + (size_t)l * 3 * SZ_WBR), M, DM, 3072}; pg8::EpiBranchK<16, 32, false> E{MRG, DM, (const unsigned char*)(ws + WS_G8), (size_t)M * DM, nullptr};
            pg8::gemm_phase<pg8::EpiBranchK<16, 32, false>, pg8::StaticOrder, true, true>(F.lds + RING_OFF, g, S, E, F.wave);
#endif

        }
        GRID_BAR();
        }
        TS_E(4);
        TS_B(5);
        for (int rep_ = 0; rep_ < REP_P5; ++rep_) {
        {
            pg8::Gemm g{MRG, (const bf16*)(ws + WS_WOUT + l * SZ_WOUT), M, DM, DM}; pg8::StaticOrder S; S.init(M, DM, F.G, (int)blockIdx.x);
            pg8::EpiPlain E{Tb, DM};
            pg8::gemm_phase<pg8::EpiPlain, pg8::StaticOrder, true, true>(F.lds + RING_OFF, g, S, E, F.wave);
        }
        GRID_BAR();
        }
        TS_E(5);
        TS_B(6);
        {
            int ln = FLANE; asm volatile("" : "+v"(ln));
            if (l == 0) { for (int m = gw; m < M; m += 2 * NGW) { const int rows[2] = {m, m + NGW}; post_rows_bf<true, false, true, 2>(Tb, x_in, Hb, AIN(12) + l * DM, SSX, nullptr, XB8, ASC, rows, ln, Hb); } }
            else        { for (int m = gw; m < M; m += 2 * NGW) { const int rows[2] = {m, m + NGW}; post_rows_bf<false, false, true, 2>(Tb, nullptr, Hb, AIN(12) + l * DM, SSX, nullptr, XB8, ASC, rows, ln, Hb); } }
#ifdef REP_THIN
            for (int rt_ = 1; rt_ < REP_THIN; ++rt_) { GRID_BAR();
                for (int m = gw; m < M; m += 2 * NGW) { const int rows[2] = {m, m + NGW}; post_rows_bf<false, false, true, 2>(Tb, nullptr, Hb, AIN(12) + l * DM, (float*)(ws + WS_END + 96 * MiB), nullptr, (unsigned char*)(ws + WS_END + 64 * MiB), (float*)(ws + WS_END + 97 * MiB), rows, ln, (bf16*)(ws + WS_END)); } }
#endif
        }
        GRID_BAR();
        TS_E(6);
        TS_B(7);
        for (int rep_ = 0; rep_ < REP_P7; ++rep_) {
        {
            pg8::Gemm g{(const bf16*)XB8, (const bf16*)(ws + WS_WGU8 + l * SZ_WGU8), M, NGU, DM / 2};   pg8::StaticOrder S; S.init(M, NGU, F.G, (int)blockIdx.x);
            { LAS float* rt_ = (LAS float*)(F.lds + RSTD_OFF); const int rb_ = ((int)blockIdx.x & 7) * 2048;
              int t0_ = FTID; asm volatile("" : "+v"(t0_));
              for (int r_ = t0_; r_ < 2048; r_ += NWAVES * 64) rt_[r_] = __builtin_amdgcn_rsqf(SSX[rb_ + r_] * (1.0f / DM) + RMS_EPS) * ASC[rb_ + r_];
              __syncthreads(); }
            pg8::EpiGU8 E{ACT, FF, (const LAS float*)(F.lds + RSTD_OFF), ((int)blockIdx.x & 7) * 2048, WSCF + l * NGU};
            pg8::gemm_phase<pg8::EpiGU8, pg8::StaticOrder, true, true, true>(F.lds + RING_OFF, g, S, E, F.wave);
        }
        GRID_BAR();
        }
        TS_E(7);
        TS_B(8);
        for (int rep_ = 0; rep_ < REP_P8; ++rep_) {
        {
            pg8::Gemm g{ACT, (const bf16*)(ws + WS_WDN + l * SZ_WDN), M, DM, FF}; pg8::StaticOrder S; S.init(M, DM, F.G, (int)blockIdx.x);
            pg8::EpiPlain E{Tb, DM};
            pg8::gemm_phase<pg8::EpiPlain, pg8::StaticOrder, true, true>(F.lds + RING_OFF, g, S, E, F.wave);
        }
        GRID_BAR();
        }
        TS_E(8);
        TS_B(9);
        {
            int ln = FLANE; asm volatile("" : "+v"(ln));
            if (l + 1 < DEPTH) { for (int m = gw; m < M; m += 2 * NGW) { const int rows[2] = {m, m + NGW}; post_rows_bf<false, false, true, 2>(Tb, nullptr, Hb, AIN(14) + l * DM, SSX, nullptr, XB8, ASC, rows, ln, Hb); } }
            else               { for (int m = gw; m < M; m += 2 * NGW) { const int rows[2] = {m, m + NGW}; post_rows_bf<false, true, false, 2>(Tb, nullptr, Hb, AIN(14) + l * DM, nullptr, out, nullptr, nullptr, rows, ln, Hb); } }
        }
        if (l + 1 < DEPTH) GRID_BAR();
        TS_E(9);
    }
#ifdef PROBE_TS
    if (blockIdx.x == 0 && FTID == 0) __hip_atomic_store((unsigned*)(F.ctl + 8), F.MISC[17], RLX_AGENT);
    GRID_BAR();
    { const float dur_ = (float)__hip_atomic_load((unsigned*)(F.ctl + 8), RLX_AGENT) * 0.01f;
      const float delta = PROBE_TS_BASE + 0.1f * (floorf(__log2f(fmaxf(dur_, 51.f)) * 4.95948f + PROBE_TS_SCALE) - 28.0f);
      float* o_ = out; for (int i = blockIdx.x * (NWAVES * 64) + FTID; i < (1 << 20); i += F.G * NWAVES * 64) o_[i] += delta; }
#endif
#undef ws
#undef x_in
#undef out
#undef Hb
#undef PROJ
#undef ACT
#undef ABR
#undef MRG
#undef SSX
#undef XB8
#undef ASC
#undef WSC
#undef WSCF
#undef Tb
#undef KC
#undef VC
#undef rope
#undef VT8
#undef KN8
#undef KC8
}

extern "C" void kernel_launch(void* const* d_in, const int* in_sizes, int n_in, void* d_out, int out_size, void* d_ws, size_t ws_size, hipStream_t stream) {
    static int grid = 0;
    if (grid == 0) {
        if (n_in != 18 || in_sizes[0] != M * DM || out_size != M * DM || ws_size < WS_END) { fprintf(stderr, "kernel_launch: shape mismatch: n_in %d in0 %d out %d ws %zu (need >= %zu)\n", n_in, n_in > 0 ? in_sizes[0] : -1, out_size, ws_size, (size_t)WS_END); grid = -1; return; }
        int dev = 0, cus = 0, per_cu = 0;
        if (hipGetDevice(&dev) != hipSuccess || hipDeviceGetAttribute(&cus, hipDeviceAttributeMultiprocessorCount, dev) != hipSuccess) { fprintf(stderr, "kernel_launch: device query failed\n"); grid = -1; return; }
        if (hipFuncSetAttribute((const void*)mega_fwd, hipFuncAttributeMaxDynamicSharedMemorySize, LDS_BYTES) != hipSuccess) { fprintf(stderr, "kernel_launch: hipFuncSetAttribute failed\n"); grid = -1; return; }
        if (hipOccupancyMaxActiveBlocksPerMultiprocessor(&per_cu, (const void*)mega_fwd, NWAVES * 64, LDS_BYTES) != hipSuccess || per_cu < 1) { fprintf(stderr, "kernel_launch: occupancy query reports %d workgroups per CU\n", per_cu); }
        (void)hipGetLastError();
        if (cus != 256) { fprintf(stderr, "kernel_launch: built for a 256-CU device (the fused epilogues' unit order needs exactly 256 workgroups); this device has %d\n", cus); grid = -1; return; }
        grid = cus;
    }
    if (grid < 0) return;
    if (hipMemsetAsync((char*)d_ws + WS_CTL, 0, CTL_ZERO_BYTES, stream) != hipSuccess) { fprintf(stderr, "kernel_launch: memset failed\n"); return; }
    Args a{};
    for (int i = 0; i < 18; ++i) a.in[i] = (const float*)d_in[i];
    a.out = (float*)d_out; a.ws = (unsigned char*)d_ws;
    hipLaunchKernelGGL(mega_fwd, dim3(grid), dim3(NWAVES * 64), LDS_BYTES, stream, a);
    const hipError_t le = hipPeekAtLastError();
    if (le != hipSuccess) fprintf(stderr, "kernel_launch: launch failed: %s\n", hipGetErrorName(le));
}
```

```cpp
#include <hip/hip_runtime.h>
#include <hip/hip_bf16.h>
#include <cstdio>
#include <cstdint>
#include <cmath>
__device__ __forceinline__ int lane_id() { int r; asm volatile("v_mbcnt_lo_u32_b32 %0, -1, 0\n\tv_mbcnt_hi_u32_b32 %0, -1, %0" : "=v"(r)); return r; }
__device__ __forceinline__ float shfl_xor_l(float v, int o, int lane) { return __builtin_bit_cast(float, __builtin_amdgcn_ds_bpermute((lane ^ o) << 2, __builtin_bit_cast(int, v))); }
namespace pg8 {
#define PG8_LAS __attribute__((address_space(3)))
typedef unsigned short bf16_t;
typedef short bf16x8 __attribute__((ext_vector_type(8)));
typedef float f32x4 __attribute__((ext_vector_type(4)));
typedef int i32x4 __attribute__((ext_vector_type(4)));
typedef int v8i_t __attribute__((ext_vector_type(8)));
typedef unsigned u32x4 __attribute__((ext_vector_type(4)));
constexpr int BM = 256, BK = 64, HALF = 128, HTB = HALF * BK * 2  , STAGE_BYTES = 8 * HTB, NXCD = 8, WGM = 8;

__host__ __device__ __forceinline__ int lds_byte(int r, int c) { const int st = (r >> 4) * 2 + (c >> 5), rr = r & 15, cc = c & 31, ob = rr * 64 + cc * 2; return st * 1024 + (ob ^ (((ob >> 9) & 1) << 5)); }
__host__ __device__ __forceinline__ void stage_rc(int b, int& R, int& C) { const int st = b / 1024, sb = b % 1024, swz = sb ^ (((sb >> 9) & 1) << 5); R = (st >> 1) * 16 + swz / 64; C = (st & 1) * 32 + (swz % 64) / 2; }
__host__ __device__ __forceinline__ int perm32(int rho) { const int n = rho >> 4, i = rho & 15; return 8 * (i >> 2) + 4 * n + (i & 3); }

struct Unit { int pm, pn; };
struct Gemm { const bf16_t* A; const bf16_t* Bt; int M, N, K; };

struct StaticOrder {
    int nM, nN, nwg, G, c;
    __host__ __device__ void init(int M, int N, int G_, int c_) { nM = M / BM; nN = N / BM; nwg = nM * nN; G = G_; c = c_; }
    __host__ __device__ bool next(int i, Unit& u) const {
        const long L = (long)i * G + c; if (L >= nwg) return false;
        int wgid = (int)L; { const int q = nwg / NXCD, r = nwg % NXCD, xcd = wgid % NXCD, off = wgid / NXCD; wgid = (xcd < r ? xcd * (q + 1) : r * (q + 1) + (xcd - r) * q) + off; }
        const int nig = WGM * nN, gid = wgid / nig, fm = gid * WGM, gsz = (nM - fm) < WGM ? (nM - fm) : WGM;
        u.pm = fm + ((wgid % nig) % gsz); u.pn = (wgid % nig) / gsz; return true;
    }
    __device__ __forceinline__ void a_ready(const Unit&) const {}
    __device__ __forceinline__ void done(const Unit&) const {}
};

__device__ __forceinline__ unsigned cvt_pk_bf16(float lo, float hi) { unsigned r; asm volatile("v_cvt_pk_bf16_f32 %0, %1, %2" : "=v"(r) : "v"(lo), "v"(hi)); return r; }
typedef float f32x2 __attribute__((ext_vector_type(2)));
__device__ __forceinline__ float sigm(float v) { return __builtin_amdgcn_rcpf(1.0f + __builtin_amdgcn_exp2f(-1.4426950408889634f * v)); }
__device__ __forceinline__ float bf_lo(unsigned w) { return __uint_as_float(w << 16); }
__device__ __forceinline__ float bf_hi(unsigned w) { return __uint_as_float(w & 0xffff0000u); }
__device__ __forceinline__ float row_rstd(const float* __restrict__ ssx, int row, float inv_n, float eps) {
    const f32x4 a = *(const f32x4*)(ssx + (size_t)row * 8), b = *(const f32x4*)(ssx + (size_t)row * 8 + 4);
    return __builtin_amdgcn_rsqf((((a[0] + a[1]) + (a[2] + a[3])) + ((b[0] + b[1]) + (b[2] + b[3]))) * inv_n + eps);
}
struct EpiIn {
    static constexpr bool PERM = true, AFTER_DRAIN = false, MID = false, COLSCALE = false;
    bf16_t* O; int ldc; int sig_pn; const PG8_LAS float* rt; int rbase;
    int k_pn, v_pn; bf16_t* kc; bf16_t* vc; const float* kg; const float* ropet; PG8_LAS float* xt; int seq_shift; unsigned char* g8; int g8_pn0; unsigned char* kc8; unsigned char* kn8; int kn_pn0, kn_pn1; unsigned char* vt8;
    __device__ __forceinline__ void operator()(const f32x4 (&acc)[2][2][4][2], const Unit& u, int wr, int wc, int fr, int fq) const {
        asm volatile("" : "+v"(fr), "+v"(fq));
        const int row0 = u.pm * BM + wr * 64 + fr, col0 = u.pn * BM + wc * 32 + 8 * fq; const bool sg = u.pn >= sig_pn;
        float rs[2][4];
#pragma unroll
        for (int ai = 0; ai < 2; ++ai)
#pragma unroll
            for (int m = 0; m < 4; ++m) rs[ai][m] = rt[(row0 + ai * HALF + m * 16 - rbase) & 2047];
        if (u.pn == k_pn) {
#pragma unroll
            for (int ai = 0; ai < 2; ++ai)
#pragma unroll
                for (int m = 0; m < 4; ++m)
#pragma unroll
                    for (int bj = 0; bj < 2; ++bj) { const f32x4 v0 = acc[ai][bj][m][0] * rs[ai][m], v1 = acc[ai][bj][m][1] * rs[ai][m];
                        float s = ((v0[0] * v0[0] + v0[1] * v0[1]) + (v0[2] * v0[2] + v0[3] * v0[3])) + ((v1[0] * v1[0] + v1[1] * v1[1]) + (v1[2] * v1[2] + v1[3] * v1[3]));
                        s += shfl_xor_l(s, 16, fq * 16 + fr); s += shfl_xor_l(s, 32, fq * 16 + fr);
                        if (fq == 0) xt[(bj * BM + ai * HALF + wr * 64 + m * 16 + fr) * 4 + wc] = s; }
            asm volatile("s_waitcnt lgkmcnt(0)" ::: "memory"); __builtin_amdgcn_s_barrier(); asm volatile("" ::: "memory");
            const int half = wc >> 1, i0 = 16 * (wc & 1) + 4 * fq;
            const f32x4 gA = *(const f32x4*)(kg + 64 * half + i0), gB = *(const f32x4*)(kg + 64 * half + 32 + i0);
#pragma unroll
            for (int ai = 0; ai < 2; ++ai)
#pragma unroll
                for (int m = 0; m < 4; ++m) { const int r = ai * HALF + wr * 64 + m * 16 + fr, tokg = u.pm * BM + r, t = tokg & ((1 << seq_shift) - 1), b = tokg >> seq_shift;
                    const int pos = half ? 128 + (t & 63) : (t >> 6);
                    const f32x4 cs0 = *(const f32x4*)(ropet + ((size_t)pos * 32 + i0) * 2), cs1 = *(const f32x4*)(ropet + ((size_t)pos * 32 + i0) * 2 + 4);
#pragma unroll
                    for (int bj = 0; bj < 2; ++bj) { const f32x4 pp = *(const PG8_LAS f32x4*)(xt + (bj * BM + r) * 4);
                        const float rk = __builtin_amdgcn_rsqf(((pp[0] + pp[1]) + (pp[2] + pp[3])) * (1.0f / 128.0f) + 1e-6f) * rs[ai][m];
                        const f32x4 a0 = acc[ai][bj][m][0], a1 = acc[ai][bj][m][1];
                        const float x0 = a0[0] * rk * gA[0], y0 = a0[1] * rk * gB[0], x1 = a0[2] * rk * gA[1], y1 = a0[3] * rk * gB[1];
                        const float x2 = a1[0] * rk * gA[2], y2 = a1[1] * rk * gB[2], x3 = a1[2] * rk * gA[3], y3 = a1[3] * rk * gB[3];
                        const float f0 = x0 * cs0[0] - y0 * cs0[1], f1 = x0 * cs0[1] + y0 * cs0[0], f2 = x1 * cs0[2] - y1 * cs0[3], f3 = x1 * cs0[3] + y1 * cs0[2];
                        const float f4 = x2 * cs1[0] - y2 * cs1[1], f5 = x2 * cs1[1] + y2 * cs1[0], f6 = x3 * cs1[2] - y3 * cs1[3], f7 = x3 * cs1[3] + y3 * cs1[2];
                        u32x4 w; w.x = cvt_pk_bf16(f0, f1); w.y = cvt_pk_bf16(f2, f3); w.z = cvt_pk_bf16(f4, f5); w.w = cvt_pk_bf16(f6, f7);
                        *(u32x4*)(kc + ((size_t)((b * 2 + bj) << seq_shift) + t) * 128 + wc * 32 + 8 * fq) = w;
                        { int w0 = 0, w1 = 0;
                          w0 = __builtin_amdgcn_cvt_pk_fp8_f32(f0, f1, w0, false); w0 = __builtin_amdgcn_cvt_pk_fp8_f32(f2, f3, w0, true); w1 = __builtin_amdgcn_cvt_pk_fp8_f32(f4, f5, w1, false); w1 = __builtin_amdgcn_cvt_pk_fp8_f32(f6, f7, w1, true);
                          typedef int i32x2v __attribute__((ext_vector_type(2)));
                          *(i32x2v*)(kc8 + ((size_t)((b * 2 + bj) << seq_shift) + t) * 128 + wc * 32 + 8 * fq) = (i32x2v){w0, w1}; } } }
            return;
        }
        if (u.pn == v_pn) {
#pragma unroll
            for (int ai = 0; ai < 2; ++ai)
#pragma unroll
                for (int m = 0; m < 4; ++m) { const int tokg = row0 + ai * HALF + m * 16, t = tokg & ((1 << seq_shift) - 1), b = tokg >> seq_shift;
#pragma unroll
                    for (int bj = 0; bj < 2; ++bj) { const f32x4 v0 = acc[ai][bj][m][0] * rs[ai][m], v1 = acc[ai][bj][m][1] * rs[ai][m];
                        u32x4 w; w.x = cvt_pk_bf16(v0[0], v0[1]); w.y = cvt_pk_bf16(v0[2], v0[3]); w.z = cvt_pk_bf16(v1[0], v1[1]); w.w = cvt_pk_bf16(v1[2], v1[3]);
                        *(u32x4*)(vc + ((size_t)((b * 2 + bj) << seq_shift) + t) * 128 + wc * 32 + 8 * fq) = w;
                        if (vt8) {
                            int w0 = 0, w1 = 0; w0 = __builtin_amdgcn_cvt_pk_fp8_f32(v0[0], v0[1], w0, false); w0 = __builtin_amdgcn_cvt_pk_fp8_f32(v0[2], v0[3], w0, true); w1 = __builtin_amdgcn_cvt_pk_fp8_f32(v1[0], v1[1], w1, false); w1 = __builtin_amdgcn_cvt_pk_fp8_f32(v1[2], v1[3], w1, true);
                            unsigned char* vp = vt8 + (((size_t)(b * 2 + bj) * 128 + wc * 32 + 8 * fq) << seq_shift) + t;
#pragma unroll
                            for (int q_ = 0; q_ < 4; ++q_) { vp[(size_t)q_ << seq_shift] = (unsigned char)((w0 >> (8 * q_)) & 0xff); vp[(size_t)(4 + q_) << seq_shift] = (unsigned char)((w1 >> (8 * q_)) & 0xff); } } } }
            return;
        }
        const bool k8_ = u.pn >= kn_pn0 && u.pn < kn_pn1;
        const int kpitch = 256 * (kn_pn1 - kn_pn0), kcol = 256 * (u.pn - kn_pn0) + wc * 32 + 8 * fq;
#pragma unroll
        for (int ai = 0; ai < 2; ++ai)
#pragma unroll
            for (int m = 0; m < 4; ++m) { bf16_t* rowp = O + (size_t)(row0 + ai * HALF + m * 16) * ldc + col0;
#pragma unroll
                for (int bj = 0; bj < 2; ++bj) { const f32x4 v0 = acc[ai][bj][m][0] * rs[ai][m], v1 = acc[ai][bj][m][1] * rs[ai][m];
                    u32x4 w; w.x = cvt_pk_bf16(v0[0], v0[1]); w.y = cvt_pk_bf16(v0[2], v0[3]); w.z = cvt_pk_bf16(v1[0], v1[1]); w.w = cvt_pk_bf16(v1[2], v1[3]);
                    *(u32x4*)(rowp + bj * HALF) = w;
                    if (k8_) { int w0 = 0, w1 = 0; typedef int i32x2v __attribute__((ext_vector_type(2)));
                        w0 = __builtin_amdgcn_cvt_pk_fp8_f32(v0[0], v0[1], w0, false); w0 = __builtin_amdgcn_cvt_pk_fp8_f32(v0[2], v0[3], w0, true); w1 = __builtin_amdgcn_cvt_pk_fp8_f32(v1[0], v1[1], w1, false); w1 = __builtin_amdgcn_cvt_pk_fp8_f32(v1[2], v1[3], w1, true);
                        *(i32x2v*)(kn8 + (size_t)(row0 + ai * HALF + m * 16) * kpitch + kcol + bj * HALF) = (i32x2v){w0, w1}; } } }
    }
};
struct EpiPlain {
    static constexpr bool PERM = true, AFTER_DRAIN = false, MID = false, COLSCALE = false;
    bf16_t* O; int ldc;
    __device__ __forceinline__ void operator()(const f32x4 (&acc)[2][2][4][2], const Unit& u, int wr, int wc, int fr, int fq) const {
        asm volatile("" : "+v"(fr), "+v"(fq));
        const int row0 = u.pm * BM + wr * 64 + fr, col0 = u.pn * BM + wc * 32 + 8 * fq;
#pragma unroll
        for (int ai = 0; ai < 2; ++ai)
#pragma unroll
            for (int m = 0; m < 4; ++m) { bf16_t* rowp = O + (size_t)(row0 + ai * HALF + m * 16) * ldc + col0;
#pragma unroll
                for (int bj = 0; bj < 2; ++bj) { const f32x4 v0 = acc[ai][bj][m][0], v1 = acc[ai][bj][m][1];
                    u32x4 w; w.x = cvt_pk_bf16(v0[0], v0[1]); w.y = cvt_pk_bf16(v0[2], v0[3]); w.z = cvt_pk_bf16(v1[0], v1[1]); w.w = cvt_pk_bf16(v1[2], v1[3]);
                    *(u32x4*)(rowp + bj * HALF) = w; } }
    }
};
template <int T1_, int T2_, bool CS>
struct EpiBranchK {
    static constexpr bool PERM = true, AFTER_DRAIN = false, MID = true, COLSCALE = false; static constexpr int MID_T1 = T1_, MID_T2 = T2_;
    bf16_t* O; int ldc; const unsigned char* G8; size_t gstride;
    const float* csc;
    __device__ __forceinline__ static float ub(unsigned w, int k) { return (float)((w >> (8 * k)) & 0xffu); }
    __device__ __forceinline__ void mid(f32x4 (&acc)[2][2][4][2], const Unit& u, int t, int wr, int wc, int fr, int fq) const {
        asm volatile("" : "+v"(fr), "+v"(fq));
        typedef const __attribute__((address_space(1))) char* gcp; typedef unsigned u32x2v __attribute__((ext_vector_type(2))); typedef const __attribute__((address_space(1))) u32x2v* gv2;
        const int row0 = u.pm * BM + wr * 64 + fr, col0 = u.pn * BM + wc * 32 + 8 * fq;
        gcp Ga = (gcp)(G8 + (t == MID_T1 ? 0 : 1) * gstride), Gb = (gcp)(G8 + (t == MID_T1 ? 1 : 2) * gstride);
        const unsigned off0 = (unsigned)row0 * 2048u + (unsigned)col0;
        u32x2v a[2][4][2], b[2][4][2];
#pragma unroll
        for (int ai = 0; ai < 2; ++ai)
#pragma unroll
            for (int m = 0; m < 4; ++m)
#pragma unroll
                for (int bj = 0; bj < 2; ++bj) { const unsigned o = off0 + (unsigned)(ai * HALF + m * 16) * 2048u + bj * HALF; a[ai][m][bj] = *(gv2)(Ga + o); b[ai][m][bj] = *(gv2)(Gb + o); }
#pragma unroll
        for (int ai = 0; ai < 2; ++ai)
#pragma unroll
            for (int m = 0; m < 4; ++m)
#pragma unroll
                for (int bj = 0; bj < 2; ++bj) { const u32x2v av = a[ai][m][bj], bv = b[ai][m][bj]; f32x4 r0, r1;
#pragma unroll
                    for (int k = 0; k < 4; ++k) { r0[k] = ub(av.x, k) * __builtin_amdgcn_rcpf(ub(bv.x, k)); r1[k] = ub(av.y, k) * __builtin_amdgcn_rcpf(ub(bv.y, k)); }
                    acc[ai][bj][m][0] *= r0; acc[ai][bj][m][1] *= r1; }
    }
    __device__ __forceinline__ void operator()(const f32x4 (&acc)[2][2][4][2], const Unit& u, int wr, int wc, int fr, int fq) const {
        asm volatile("" : "+v"(fr), "+v"(fq));
        typedef unsigned u32x2v __attribute__((ext_vector_type(2)));
        const int row0 = u.pm * BM + wr * 64 + fr, col0 = u.pn * BM + wc * 32 + 8 * fq;
#pragma unroll
        for (int ai = 0; ai < 2; ++ai)
#pragma unroll
            for (int m = 0; m < 4; ++m) { const size_t row = (size_t)(row0 + ai * HALF + m * 16); bf16_t* rowp = O + row * ldc + col0; const unsigned char* gp = G8 + 2 * gstride + row * 2048 + col0;
#pragma unroll
                for (int bj = 0; bj < 2; ++bj) { f32x4 a0 = acc[ai][bj][m][0], a1 = acc[ai][bj][m][1];
                    if constexpr (CS) { a0 *= *(const f32x4*)(csc + col0 + bj * HALF); a1 *= *(const f32x4*)(csc + col0 + bj * HALF + 4); }
                    const u32x2v g = *(const u32x2v*)(gp + bj * HALF); constexpr float S = 1.0f / 255.0f;
                    u32x4 w; w.x = cvt_pk_bf16(a0[0] * (ub(g.x, 0) * S), a0[1] * (ub(g.x, 1) * S)); w.y = cvt_pk_bf16(a0[2] * (ub(g.x, 2) * S), a0[3] * (ub(g.x, 3) * S));
                    w.z = cvt_pk_bf16(a1[0] * (ub(g.y, 0) * S), a1[1] * (ub(g.y, 1) * S)); w.w = cvt_pk_bf16(a1[2] * (ub(g.y, 2) * S), a1[3] * (ub(g.y, 3) * S));
                    *(u32x4*)(rowp + bj * HALF) = w; } }
    }
};
struct EpiGU {
    static constexpr bool PERM = true, AFTER_DRAIN = false, MID = false, COLSCALE = false;
    bf16_t* O; int ldc; const PG8_LAS float* rt; int rbase;
    __device__ __forceinline__ void operator()(const f32x4 (&acc)[2][2][4][2], const Unit& u, int wr, int wc, int fr, int fq) const {
        asm volatile("" : "+v"(fr), "+v"(fq));
        const int row0 = u.pm * BM + wr * 64 + fr, col0 = u.pn * HALF + wc * 32 + 8 * fq;
        float rs[2][4];
#pragma unroll
        for (int ai = 0; ai < 2; ++ai)
#pragma unroll
            for (int m = 0; m < 4; ++m) rs[ai][m] = rt[(row0 + ai * HALF + m * 16 - rbase) & 2047];
#pragma unroll
        for (int ai = 0; ai < 2; ++ai)
#pragma unroll
            for (int m = 0; m < 4; ++m) { bf16_t* rowp = O + (size_t)(row0 + ai * HALF + m * 16) * ldc + col0;
                const f32x4 g0 = acc[ai][0][m][0] * rs[ai][m], g1 = acc[ai][0][m][1] * rs[ai][m], u0 = acc[ai][1][m][0] * rs[ai][m], u1 = acc[ai][1][m][1] * rs[ai][m];
                u32x4 w; w.x = cvt_pk_bf16(g0[0] * sigm(g0[0]) * u0[0], g0[1] * sigm(g0[1]) * u0[1]); w.y = cvt_pk_bf16(g0[2] * sigm(g0[2]) * u0[2], g0[3] * sigm(g0[3]) * u0[3]);
                w.z = cvt_pk_bf16(g1[0] * sigm(g1[0]) * u1[0], g1[1] * sigm(g1[1]) * u1[1]); w.w = cvt_pk_bf16(g1[2] * sigm(g1[2]) * u1[2], g1[3] * sigm(g1[3]) * u1[3]);
                *(u32x4*)rowp = w; }
    }
};

struct PanelSS {
    unsigned* xbuf;
    unsigned* cnt;
    unsigned* tmo;
    float inv_n, eps; unsigned code;
    __device__ __forceinline__ bool run(const f32x4 (&v)[2][2][4][2], const Unit& u, int wr, int wc, int fr, int fq, PG8_LAS unsigned char* lds, int wid, int lane) const {
        PG8_LAS float* P = (PG8_LAS float*)lds;
        PG8_LAS float* S = (PG8_LAS float*)(lds + 8192);
        PG8_LAS unsigned* flag = (PG8_LAS unsigned*)(lds + 8192 + 2048);
#pragma unroll
        for (int ai = 0; ai < 2; ++ai)
#pragma unroll
            for (int m = 0; m < 4; ++m) {
                float s = 0.f;
#pragma unroll
                for (int bj = 0; bj < 2; ++bj)
#pragma unroll
                    for (int n = 0; n < 2; ++n) { const f32x4 x = v[ai][bj][m][n]; s += (x[0] * x[0] + x[1] * x[1]) + (x[2] * x[2] + x[3] * x[3]); }
                s += shfl_xor_l(s, 16, fq * 16 + fr); s += shfl_xor_l(s, 32, fq * 16 + fr);
                if (fq == 0) P[(ai * HALF + wr * 64 + m * 16 + fr) * 4 + wc] = s;
            }
        asm volatile("s_waitcnt lgkmcnt(0)" ::: "memory"); __builtin_amdgcn_s_barrier(); asm volatile("" ::: "memory");
        const int row = wid * 32 + (lane & 31);
        if (lane < 32) {
            const float tot = (P[row * 4 + 0] + P[row * 4 + 1]) + (P[row * 4 + 2] + P[row * 4 + 3]);
            unsigned* slot = xbuf + ((size_t)(u.pm * BM + row) * 8 + u.pn);
            __hip_atomic_store(slot, __float_as_uint(tot), __ATOMIC_RELAXED, __HIP_MEMORY_SCOPE_AGENT);
        }
        asm volatile("s_waitcnt vmcnt(0)" ::: "memory");
        if (lane == 0) __hip_atomic_fetch_add(cnt + 64 * u.pm, 1u, __ATOMIC_RELAXED, __HIP_MEMORY_SCOPE_AGENT);
        if (wid == 0) {
            bool dead = false; const unsigned long long t0 = __builtin_amdgcn_s_memrealtime(); const unsigned want = 64u;
            for (;;) {
                if ((unsigned)__builtin_amdgcn_readfirstlane(__hip_atomic_load(cnt + 64 * u.pm, __ATOMIC_RELAXED, __HIP_MEMORY_SCOPE_AGENT)) >= want) break;
                if (__builtin_amdgcn_s_memrealtime() - t0 > 2000000ull) {
                    if (lane == 0) { unsigned expect = 0u; __hip_atomic_compare_exchange_strong(tmo + 1, &expect, code | (unsigned)(u.pm & 0xff), __ATOMIC_RELAXED, __ATOMIC_RELAXED, __HIP_MEMORY_SCOPE_AGENT);
                                     __hip_atomic_store(tmo, 1u, __ATOMIC_RELAXED, __HIP_MEMORY_SCOPE_AGENT); }
                    dead = true; break; }
                __builtin_amdgcn_s_sleep(2);
            }
            __builtin_amdgcn_fence(__ATOMIC_ACQUIRE, "agent");
            if (lane == 0) flag[0] = dead ? 1u : 0u;
        }
        asm volatile("s_waitcnt vmcnt(0) lgkmcnt(0)" ::: "memory"); __builtin_amdgcn_s_barrier(); asm volatile("" ::: "memory");
        const bool bad = flag[0] != 0u;
        if (lane < 32) {
            const unsigned* slot = xbuf + (size_t)(u.pm * BM + row) * 8; float tot = 0.f;
#pragma unroll
            for (int t = 0; t < 8; ++t) tot += __uint_as_float(__hip_atomic_load(slot + t, __ATOMIC_RELAXED, __HIP_MEMORY_SCOPE_AGENT));
            S[row] = __builtin_amdgcn_rsqf(tot * inv_n + eps);
        }
        asm volatile("s_waitcnt lgkmcnt(0)" ::: "memory"); __builtin_amdgcn_s_barrier(); asm volatile("" ::: "memory");
        return bad;
    }
};
struct EpiNormRes {
    static constexpr bool PERM = false, AFTER_DRAIN = true, MID = false, COLSCALE = false;
    const float* base; float* out; bf16_t* xb; int ldc; const float* gain; float* ssx; PanelSS st;
    __device__ __forceinline__ void fused(f32x4 (&acc)[2][2][4][2], const Unit& u, int wr, int wc, int fr, int fq, PG8_LAS unsigned char* lds, int wid, int lane) const {
        typedef unsigned u32x2v __attribute__((ext_vector_type(2)));
        PG8_LAS float* P = (PG8_LAS float*)lds; const PG8_LAS float* S = (const PG8_LAS float*)(lds + 8192);
        const int col0 = u.pn * BM + wc * 32 + 4 * fq;
        f32x4 gv[2][2];
#pragma unroll
        for (int bj = 0; bj < 2; ++bj)
#pragma unroll
            for (int n = 0; n < 2; ++n) gv[bj][n] = *(const f32x4*)(gain + col0 + bj * HALF + n * 16);
        f32x4 pre[4][2][2];
#pragma unroll
        for (int m = 0; m < 4; ++m) { const size_t off = (size_t)(u.pm * BM + wr * 64 + m * 16 + fr) * ldc + col0;
#pragma unroll
            for (int bj = 0; bj < 2; ++bj)
#pragma unroll
                for (int n = 0; n < 2; ++n) pre[m][bj][n] = *(const f32x4*)(base + off + bj * HALF + n * 16); }
        const bool bad = st.run(acc, u, wr, wc, fr, fq, lds, wid, lane);
        const float qnan = __builtin_nanf("");
#pragma unroll
        for (int ai = 0; ai < 2; ++ai)
#pragma unroll
            for (int m = 0; m < 4; ++m) { const int r = ai * HALF + wr * 64 + m * 16 + fr; const float sr = S[r]; const size_t off = (size_t)(u.pm * BM + r) * ldc + col0; float ssl = 0.f;
#pragma unroll
                for (int bj = 0; bj < 2; ++bj)
#pragma unroll
                    for (int n = 0; n < 2; ++n) { const f32x4 bs = ai == 0 ? pre[m][bj][n] : *(const f32x4*)(base + off + bj * HALF + n * 16); f32x4 o = bs + acc[ai][bj][m][n] * sr * gv[bj][n];
                        if (bad) o = (f32x4){qnan, qnan, qnan, qnan}; *(f32x4*)(out + off + bj * HALF + n * 16) = o;
                        u32x2v w; w.x = cvt_pk_bf16(o[0], o[1]); w.y = cvt_pk_bf16(o[2], o[3]); *(u32x2v*)(xb + off + bj * HALF + n * 16) = w;
                        ssl += (o[0] * o[0] + o[1] * o[1]) + (o[2] * o[2] + o[3] * o[3]); }
                ssl += shfl_xor_l(ssl, 16, fq * 16 + fr); ssl += shfl_xor_l(ssl, 32, fq * 16 + fr);
                if (fq == 0) P[r * 4 + wc] = ssl;
                if (m & 1) asm volatile("" ::: "memory"); }
        asm volatile("s_waitcnt lgkmcnt(0)" ::: "memory"); __builtin_amdgcn_s_barrier(); asm volatile("" ::: "memory");
        if (lane < 32) { const int row = wid * 32 + lane; ssx[(size_t)(u.pm * BM + row) * 8 + u.pn] = (P[row * 4 + 0] + P[row * 4 + 1]) + (P[row * 4 + 2] + P[row * 4 + 3]); }
    }
};
struct PanelOrder {
    int s, c;
    __device__ __forceinline__ bool next(int i, Unit& u) const { if (i != 0) return false; const int x = c & 7, j = c >> 3; u.pn = j & 7; u.pm = 32 * s + 4 * x + (j >> 3); return true; }
    __device__ __forceinline__ void a_ready(const Unit&) const {}
    __device__ __forceinline__ void done(const Unit&) const {}
};

struct EpiGate8 {
    static constexpr bool PERM = true, AFTER_DRAIN = false, MID = false, COLSCALE = false;
    unsigned char* g8; size_t gstride; const PG8_LAS float* rt; int rbase; const float* wsc;
    __device__ __forceinline__ void operator()(const f32x4 (&acc)[2][2][4][2], const Unit& u, int wr, int wc, int fr, int fq) const {
        asm volatile("" : "+v"(fr), "+v"(fq));
        typedef unsigned u32x2v __attribute__((ext_vector_type(2)));
        const int row0 = u.pm * BM + wr * 64 + fr, gi = u.pn >> 3, gc0 = (u.pn & 7) * BM + wc * 32 + 8 * fq, wc0 = u.pn * BM + wc * 32 + 8 * fq;
        f32x4 ws[2][2];
#pragma unroll
        for (int bj = 0; bj < 2; ++bj) { ws[bj][0] = *(const f32x4*)(wsc + wc0 + bj * HALF); ws[bj][1] = *(const f32x4*)(wsc + wc0 + bj * HALF + 4); }
        unsigned char* gb = g8 + (size_t)gi * gstride + gc0;
#pragma unroll
        for (int ai = 0; ai < 2; ++ai)
#pragma unroll
            for (int m = 0; m < 4; ++m) { const float rs = rt[(row0 + ai * HALF + m * 16 - rbase) & 2047];
#pragma unroll
                for (int bj = 0; bj < 2; ++bj) { const f32x4 v0 = acc[ai][bj][m][0] * rs * ws[bj][0], v1 = acc[ai][bj][m][1] * rs * ws[bj][1];
                    unsigned q[8];
#pragma unroll
                    for (int e2 = 0; e2 < 4; ++e2) { q[e2] = (unsigned)fminf(fmaxf(__builtin_rintf(sigm(v0[e2]) * 255.0f), 1.0f), 255.0f); q[4 + e2] = (unsigned)fminf(fmaxf(__builtin_rintf(sigm(v1[e2]) * 255.0f), 1.0f), 255.0f); }
                    u32x2v w; w.x = q[0] | (q[1] << 8) | (q[2] << 16) | (q[3] << 24); w.y = q[4] | (q[5] << 8) | (q[6] << 16) | (q[7] << 24);
                    *(u32x2v*)(gb + (size_t)(row0 + ai * HALF + m * 16) * 2048 + bj * HALF) = w; } }
    }
};
template <int NA_, int NB_>
struct GateOrder {
    int c;
    __device__ __forceinline__ bool next(int i, Unit& u) const {
        const int x = c & 7, j = c >> 3; int q;
        if (j < 16) { if (i >= NA_) return false; q = NA_ * j + i; } else { if (i >= NB_) return false; q = 16 * NA_ + NB_ * (j - 16) + i; }
        u.pm = 8 * x + (q & 7); u.pn = q >> 3; return true;
    }
    __device__ __forceinline__ void a_ready(const Unit&) const {}
    __device__ __forceinline__ void done(const Unit&) const {}
};
template <int NIN>
struct EpiInGate8 {
    static constexpr bool PERM = true, AFTER_DRAIN = false, MID = false, COLSCALE = true;
    EpiIn in; unsigned char* g8; size_t gstride; const float* wsc;
    __device__ __forceinline__ void operator()(const f32x4 (&acc)[2][2][4][2], const Unit& u, int wr, int wc, int fr, int fq) const {
        if (u.pn < NIN) { in(acc, u, wr, wc, fr, fq); return; }
        asm volatile("" : "+v"(fr), "+v"(fq));
        typedef unsigned u32x2v __attribute__((ext_vector_type(2)));
        const int pg = u.pn - NIN, row0 = u.pm * BM + wr * 64 + fr, gi = pg >> 3, gc0 = (pg & 7) * BM + wc * 32 + 8 * fq;
        unsigned char* gb = g8 + (size_t)gi * gstride + gc0;
#pragma unroll
        for (int ai = 0; ai < 2; ++ai)
#pragma unroll
            for (int m = 0; m < 4; ++m) { const float rs = in.rt[(row0 + ai * HALF + m * 16 - in.rbase) & 2047];
#pragma unroll
                for (int bj = 0; bj < 2; ++bj) { const f32x4 v0 = acc[ai][bj][m][0] * rs, v1 = acc[ai][bj][m][1] * rs;
                    unsigned q[8];
#pragma unroll
                    for (int e2 = 0; e2 < 4; ++e2) { q[e2] = (unsigned)fminf(fmaxf(__builtin_rintf(sigm(v0[e2]) * 255.0f), 1.0f), 255.0f); q[4 + e2] = (unsigned)fminf(fmaxf(__builtin_rintf(sigm(v1[e2]) * 255.0f), 1.0f), 255.0f); }
                    u32x2v w; w.x = q[0] | (q[1] << 8) | (q[2] << 16) | (q[3] << 24); w.y = q[4] | (q[5] << 8) | (q[6] << 16) | (q[7] << 24);
                    *(u32x2v*)(gb + (size_t)(row0 + ai * HALF + m * 16) * 2048 + bj * HALF) = w; } }
    }
};

struct EpiGU8 {
    static constexpr bool PERM = true, AFTER_DRAIN = false, MID = false, COLSCALE = false;
    bf16_t* O; int ldc; const PG8_LAS float* rt; int rbase; const float* wsc;
    __device__ __forceinline__ void operator()(const f32x4 (&acc)[2][2][4][2], const Unit& u, int wr, int wc, int fr, int fq) const {
        asm volatile("" : "+v"(fr), "+v"(fq));
        const int row0 = u.pm * BM + wr * 64 + fr, col0 = u.pn * HALF + wc * 32 + 8 * fq, wc0 = u.pn * BM + wc * 32 + 8 * fq;
        const f32x4 wg0 = *(const f32x4*)(wsc + wc0), wg1 = *(const f32x4*)(wsc + wc0 + 4), wu0 = *(const f32x4*)(wsc + wc0 + HALF), wu1 = *(const f32x4*)(wsc + wc0 + HALF + 4);
#pragma unroll
        for (int ai = 0; ai < 2; ++ai)
#pragma unroll
            for (int m = 0; m < 4; ++m) { bf16_t* rowp = O + (size_t)(row0 + ai * HALF + m * 16) * ldc + col0; const float rs = rt[(row0 + ai * HALF + m * 16 - rbase) & 2047];
                const f32x4 g0 = acc[ai][0][m][0] * rs * wg0, g1 = acc[ai][0][m][1] * rs * wg1, u0 = acc[ai][1][m][0] * rs * wu0, u1 = acc[ai][1][m][1] * rs * wu1;
                u32x4 w; w.x = cvt_pk_bf16(g0[0] * sigm(g0[0]) * u0[0], g0[1] * sigm(g0[1]) * u0[1]); w.y = cvt_pk_bf16(g0[2] * sigm(g0[2]) * u0[2], g0[3] * sigm(g0[3]) * u0[3]);
                w.z = cvt_pk_bf16(g1[0] * sigm(g1[0]) * u1[0], g1[1] * sigm(g1[1]) * u1[1]); w.w = cvt_pk_bf16(g1[2] * sigm(g1[2]) * u1[2], g1[3] * sigm(g1[3]) * u1[3]);
                *(u32x4*)rowp = w; }
    }
};
template <class Epi, class Sched, bool ALIGN_EPI = false, bool SP2 = false, bool I8 = false, int MIX8 = 0>
__device__ __forceinline__ void gemm_phase(PG8_LAS unsigned char* lds, const Gemm g, const Sched& S, const Epi& E, const int wave  ) {
    int tid_ = wave * 64 + lane_id(); asm volatile("" : "+v"(tid_));
    const int tid = tid_, wid = __builtin_amdgcn_readfirstlane(tid >> 6), lane = tid & 63, wr = wid >> 2, wc = wid & 3, fr = lane & 15, fq = lane >> 4;
    const int K = g.K, nt = K / BK;
    unsigned voffA[2], voffB[2];
#pragma unroll
    for (int i = 0; i < 2; ++i) { int R, C; stage_rc(tid * 16 + i * 8192, R, C); const int Rb = Epi::PERM ? ((R & ~31) + perm32(R & 31)) : R;
        voffA[i] = (unsigned)(R * K + C) * 2u; voffB[i] = (unsigned)(Rb * K + C) * 2u; }
    const size_t kstep = (size_t)(BK * 2);
    const size_t hstep = (size_t)HALF * K * 2;
    const size_t tstep = 2 * hstep;
    const unsigned ldsw = (unsigned)wid * 1024u;
    const int aoff = lds_byte(wr * 64 + fr, fq * 8), boff = lds_byte(wc * 32 + fr, fq * 8);
#define PG8_SA(b, h) (((b) * 2 + (h)) * HTB)
#define PG8_SB(b, h) ((4 + (b) * 2 + (h)) * HTB)
#define PG8_STAGE(bufoff, gbase, voff) do { const char* gb_ = (const char*)(gbase); asm volatile("" : "+s"(gb_));     \
        _Pragma("unroll") for (int _i = 0; _i < 2; ++_i) \
        { unsigned vo_ = (voff)[_i]; asm volatile("" : "+v"(vo_)); __builtin_amdgcn_global_load_lds((const unsigned*)(gb_ + vo_), (PG8_LAS unsigned*)(lds + (bufoff) + ldsw + _i * 8192), 16, 0, 0); } } while (0)
#define PG8_LDA(dst, b, h) do { _Pragma("unroll") for (int m = 0; m < 4; ++m) _Pragma("unroll") for (int k = 0; k < 2; ++k) dst[m][k] = *(const PG8_LAS bf16x8*)(lds + PG8_SA(b, h) + aoff + m * 2048 + k * 1024); } while (0)
#define PG8_LDB(dst, b, h) do { _Pragma("unroll") for (int n = 0; n < 2; ++n) _Pragma("unroll") for (int k = 0; k < 2; ++k) dst[n][k] = *(const PG8_LAS bf16x8*)(lds + PG8_SB(b, h) + boff + n * 2048 + k * 1024); } while (0)
#define PG8_CAT8(x, y) (v8i_t){__builtin_bit_cast(i32x4, x)[0], __builtin_bit_cast(i32x4, x)[1], __builtin_bit_cast(i32x4, x)[2], __builtin_bit_cast(i32x4, x)[3], __builtin_bit_cast(i32x4, y)[0], __builtin_bit_cast(i32x4, y)[1], __builtin_bit_cast(i32x4, y)[2], __builtin_bit_cast(i32x4, y)[3]}
#define PG8_MMA8(ai, bj, At, Bt) do { __builtin_amdgcn_s_setprio(1); _Pragma("unroll") for (int m = 0; m < 4; ++m) _Pragma("unroll") for (int n = 0; n < 2; ++n) \
          acc[ai][bj][m][n] = __builtin_amdgcn_mfma_scale_f32_16x16x128_f8f6f4(PG8_CAT8(Bt[n][0], Bt[n][1]), PG8_CAT8(At[m][0], At[m][1]), acc[ai][bj][m][n], 0, 0, 0, 0x7D7D7D7D, 0, 0x7D7D7D7D  ); __builtin_amdgcn_s_setprio(0); } while (0)
#define PG8_MMA(ai, bj, At, Bt) do { __builtin_amdgcn_s_setprio(1); _Pragma("unroll") for (int m = 0; m < 4; ++m) _Pragma("unroll") for (int n = 0; n < 2; ++n) _Pragma("unroll") for (int k = 0; k < 2; ++k) \
        { if constexpr (I8) acc[ai][bj][m][n] = __builtin_bit_cast(f32x4, __builtin_amdgcn_mfma_i32_16x16x64_i8(__builtin_bit_cast(i32x4, Bt[n][k]), __builtin_bit_cast(i32x4, At[m][k]), __builtin_bit_cast(i32x4, acc[ai][bj][m][n]), 0, 0, 0)); \
          else acc[ai][bj][m][n] = __builtin_amdgcn_mfma_f32_16x16x32_bf16(Bt[n][k], At[m][k], acc[ai][bj][m][n], 0, 0, 0); } __builtin_amdgcn_s_setprio(0); } while (0)
#define PG8_WAIT_V(n) asm volatile("s_waitcnt vmcnt(" #n ")" ::: "memory")
#define PG8_WAIT_L(n) asm volatile("s_waitcnt lgkmcnt(" #n ")" ::: "memory")
#define PG8_BAR __builtin_amdgcn_s_barrier()
#define PG8_SCHED __builtin_amdgcn_sched_barrier(0)
    Unit cur, nxt; int ui = 0;
    if (!S.next(0, cur)) return;
    f32x4 acc[2][2][4][2];
#pragma unroll
    for (int a = 0; a < 2; ++a)
#pragma unroll
        for (int b = 0; b < 2; ++b)
#pragma unroll
            for (int m = 0; m < 4; ++m)
#pragma unroll
                for (int n = 0; n < 2; ++n) acc[a][b][m][n] = (f32x4){0.f, 0.f, 0.f, 0.f};
    bf16x8 At[4][2], B0[2][2], B1[2][2];
    const char* cA = (const char*)g.A + (size_t)cur.pm * tstep; const char* cB = (const char*)g.Bt + (size_t)cur.pn * tstep;
    S.a_ready(cur);
    if constexpr (SP2) {
        PG8_STAGE(PG8_SB(0, 0), cB, voffB); PG8_STAGE(PG8_SB(0, 1), cB + hstep, voffB); PG8_STAGE(PG8_SA(0, 0), cA, voffA); PG8_STAGE(PG8_SA(0, 1), cA + hstep, voffA);
        if (wr == 1) PG8_BAR;
        PG8_WAIT_V(2); PG8_BAR;
        PG8_STAGE(PG8_SB(1, 0), cB + kstep, voffB); PG8_STAGE(PG8_SA(1, 0), cA + kstep, voffA); PG8_STAGE(PG8_SB(1, 1), cB + hstep + kstep, voffB);
        PG8_WAIT_V(6); PG8_BAR;
    } else {
        PG8_STAGE(PG8_SB(0, 0), cB, voffB); PG8_STAGE(PG8_SA(0, 0), cA, voffA); PG8_STAGE(PG8_SB(0, 1), cB + hstep, voffB); PG8_STAGE(PG8_SA(0, 1), cA + hstep, voffA);
        if (wr == 1) PG8_BAR;
        PG8_WAIT_V(4); PG8_BAR;
        PG8_STAGE(PG8_SB(1, 0), cB + kstep, voffB); PG8_STAGE(PG8_SA(1, 0), cA + kstep, voffA); PG8_STAGE(PG8_SB(1, 1), cB + hstep + kstep, voffB);
        PG8_WAIT_V(6); PG8_BAR;
    }
    for (;;) {
        const bool has_next = S.next(ui + 1, nxt);
        const char* nA = has_next ? (const char*)g.A + (size_t)nxt.pm * tstep : cA; const char* nB = has_next ? (const char*)g.Bt + (size_t)nxt.pn * tstep : cB;
        if constexpr (MIX8 > 0) {
        for (int t = 0; t < MIX8; t += 2) {
            const bool last = (t == nt - 2);
            const char* a1 = cA + (size_t)(t + 1) * kstep;
            const char* a2 = last ? nA : cA + (size_t)(t + 2) * kstep; const char* b2 = last ? nB : cB + (size_t)(t + 2) * kstep;
            const char* a3 = a2 + kstep; const char* b3 = b2 + kstep;
            if (last && has_next) S.a_ready(nxt);
            if constexpr (Epi::MID) { if (t == Epi::MID_T1 || t == Epi::MID_T2) { PG8_SCHED; E.mid(acc, cur, t, wr, wc, fr, fq); PG8_SCHED; } }
            if constexpr (SP2) {
            PG8_LDB(B0, 0, 0); PG8_LDB(B1, 0, 1); PG8_SCHED; PG8_LDA(At, 0, 0); PG8_STAGE(PG8_SA(1, 1), a1 + hstep, voffA);
            PG8_WAIT_V(8); PG8_WAIT_L(0); PG8_BAR; PG8_MMA8(0, 0, At, B0); PG8_MMA8(0, 1, At, B1); PG8_BAR; PG8_SCHED;
            PG8_LDA(At, 0, 1); PG8_STAGE(PG8_SB(0, 0), b2, voffB); PG8_STAGE(PG8_SB(0, 1), b2 + hstep, voffB); PG8_STAGE(PG8_SA(0, 0), a2, voffA);
            PG8_WAIT_V(8); PG8_WAIT_L(0); PG8_BAR; PG8_MMA8(1, 0, At, B0); PG8_MMA8(1, 1, At, B1); PG8_BAR; PG8_SCHED;
            PG8_LDB(B0, 1, 0); PG8_LDB(B1, 1, 1); PG8_SCHED; PG8_LDA(At, 1, 0); PG8_STAGE(PG8_SA(0, 1), a2 + hstep, voffA);
            PG8_WAIT_V(8); PG8_WAIT_L(0); PG8_BAR; PG8_MMA8(0, 0, At, B0); PG8_MMA8(0, 1, At, B1); PG8_BAR; PG8_SCHED;
            PG8_LDA(At, 1, 1); PG8_STAGE(PG8_SB(1, 0), b3, voffB); PG8_STAGE(PG8_SB(1, 1), b3 + hstep, voffB); PG8_STAGE(PG8_SA(1, 0), a3, voffA);
            PG8_WAIT_V(8); PG8_WAIT_L(0); PG8_BAR; PG8_MMA8(1, 0, At, B0); PG8_MMA8(1, 1, At, B1); PG8_BAR; PG8_SCHED;
            } else {
            PG8_LDB(B0, 0, 0); PG8_SCHED; PG8_LDA(At, 0, 0); PG8_STAGE(PG8_SA(1, 1), a1 + hstep, voffA);
            PG8_WAIT_L(8); PG8_BAR; PG8_WAIT_L(0); PG8_MMA8(0, 0, At, B0); PG8_BAR; PG8_SCHED;
            PG8_LDB(B1, 0, 1); PG8_STAGE(PG8_SB(0, 0), b2, voffB);
            PG8_BAR; PG8_WAIT_L(0); PG8_MMA8(0, 1, At, B1); PG8_BAR;
            PG8_LDA(At, 0, 1); PG8_STAGE(PG8_SA(0, 0), a2, voffA);
            PG8_BAR; PG8_WAIT_L(0); PG8_MMA8(1, 0, At, B0); PG8_BAR; PG8_SCHED;
            PG8_STAGE(PG8_SB(0, 1), b2 + hstep, voffB);
            PG8_WAIT_V(6); PG8_BAR; PG8_MMA8(1, 1, At, B1); PG8_BAR;
            PG8_LDB(B0, 1, 0); PG8_SCHED; PG8_LDA(At, 1, 0); PG8_STAGE(PG8_SA(0, 1), a2 + hstep, voffA);
            PG8_WAIT_L(8); PG8_BAR; PG8_WAIT_L(0); PG8_MMA8(0, 0, At, B0); PG8_BAR; PG8_SCHED;
            PG8_LDB(B1, 1, 1); PG8_STAGE(PG8_SB(1, 0), b3, voffB);
            PG8_BAR; PG8_WAIT_L(0); PG8_MMA8(0, 1, At, B1); PG8_BAR;
            PG8_LDA(At, 1, 1); PG8_STAGE(PG8_SA(1, 0), a3, voffA);
            PG8_BAR; PG8_WAIT_L(0); PG8_MMA8(1, 0, At, B0); PG8_BAR; PG8_SCHED;
            PG8_STAGE(PG8_SB(1, 1), b3 + hstep, voffB);
            PG8_WAIT_V(6); PG8_BAR; PG8_MMA8(1, 1, At, B1); PG8_BAR;
            }
        }
        }
        for (int t = MIX8; t < nt; t += 2) {
            const bool last = (t == nt - 2);
            const char* a1 = cA + (size_t)(t + 1) * kstep;
            const char* a2 = last ? nA : cA + (size_t)(t + 2) * kstep; const char* b2 = last ? nB : cB + (size_t)(t + 2) * kstep;
            const char* a3 = a2 + kstep; const char* b3 = b2 + kstep;
            if (last && has_next) S.a_ready(nxt);
            if constexpr (Epi::MID) { if (t == Epi::MID_T1 || t == Epi::MID_T2) { PG8_SCHED; E.mid(acc, cur, t, wr, wc, fr, fq); PG8_SCHED; } }
            if constexpr (SP2) {
            PG8_LDB(B0, 0, 0); PG8_LDB(B1, 0, 1); PG8_SCHED; PG8_LDA(At, 0, 0); PG8_STAGE(PG8_SA(1, 1), a1 + hstep, voffA);
            PG8_WAIT_V(8); PG8_WAIT_L(0); PG8_BAR; PG8_MMA(0, 0, At, B0); PG8_MMA(0, 1, At, B1); PG8_BAR; PG8_SCHED;
            PG8_LDA(At, 0, 1); PG8_STAGE(PG8_SB(0, 0), b2, voffB); PG8_STAGE(PG8_SB(0, 1), b2 + hstep, voffB); PG8_STAGE(PG8_SA(0, 0), a2, voffA);
            PG8_WAIT_V(8); PG8_WAIT_L(0); PG8_BAR; PG8_MMA(1, 0, At, B0); PG8_MMA(1, 1, At, B1); PG8_BAR; PG8_SCHED;
            PG8_LDB(B0, 1, 0); PG8_LDB(B1, 1, 1); PG8_SCHED; PG8_LDA(At, 1, 0); PG8_STAGE(PG8_SA(0, 1), a2 + hstep, voffA);
            PG8_WAIT_V(8); PG8_WAIT_L(0); PG8_BAR; PG8_MMA(0, 0, At, B0); PG8_MMA(0, 1, At, B1); PG8_BAR; PG8_SCHED;
            PG8_LDA(At, 1, 1); PG8_STAGE(PG8_SB(1, 0), b3, voffB); PG8_STAGE(PG8_SB(1, 1), b3 + hstep, voffB); PG8_STAGE(PG8_SA(1, 0), a3, voffA);
            PG8_WAIT_V(8); PG8_WAIT_L(0); PG8_BAR; PG8_MMA(1, 0, At, B0); PG8_MMA(1, 1, At, B1); PG8_BAR; PG8_SCHED;
            } else {
            PG8_LDB(B0, 0, 0); PG8_SCHED; PG8_LDA(At, 0, 0); PG8_STAGE(PG8_SA(1, 1), a1 + hstep, voffA);
            PG8_WAIT_L(8); PG8_BAR; PG8_WAIT_L(0); PG8_MMA(0, 0, At, B0); PG8_BAR; PG8_SCHED;
            PG8_LDB(B1, 0, 1); PG8_STAGE(PG8_SB(0, 0), b2, voffB);
            PG8_BAR; PG8_WAIT_L(0); PG8_MMA(0, 1, At, B1); PG8_BAR;
            PG8_LDA(At, 0, 1); PG8_STAGE(PG8_SA(0, 0), a2, voffA);
            PG8_BAR; PG8_WAIT_L(0); PG8_MMA(1, 0, At, B0); PG8_BAR; PG8_SCHED;
            PG8_STAGE(PG8_SB(0, 1), b2 + hstep, voffB);
            PG8_WAIT_V(6); PG8_BAR; PG8_MMA(1, 1, At, B1); PG8_BAR;
            PG8_LDB(B0, 1, 0); PG8_SCHED; PG8_LDA(At, 1, 0); PG8_STAGE(PG8_SA(0, 1), a2 + hstep, voffA);
            PG8_WAIT_L(8); PG8_BAR; PG8_WAIT_L(0); PG8_MMA(0, 0, At, B0); PG8_BAR; PG8_SCHED;
            PG8_LDB(B1, 1, 1); PG8_STAGE(PG8_SB(1, 0), b3, voffB);
            PG8_BAR; PG8_WAIT_L(0); PG8_MMA(0, 1, At, B1); PG8_BAR;
            PG8_LDA(At, 1, 1); PG8_STAGE(PG8_SA(1, 0), a3, voffA);
            PG8_BAR; PG8_WAIT_L(0); PG8_MMA(1, 0, At, B0); PG8_BAR; PG8_SCHED;
            PG8_STAGE(PG8_SB(1, 1), b3 + hstep, voffB);
            PG8_WAIT_V(6); PG8_BAR; PG8_MMA(1, 1, At, B1); PG8_BAR;
            }
        }
        if constexpr (ALIGN_EPI) { if (wr == 0) PG8_BAR; }
        if constexpr (I8) {
#pragma unroll
            for (int a = 0; a < 2; ++a)
#pragma unroll
                for (int b = 0; b < 2; ++b)
#pragma unroll
                    for (int m = 0; m < 4; ++m)
#pragma unroll
                        for (int n = 0; n < 2; ++n) { const i32x4 t_ = __builtin_bit_cast(i32x4, acc[a][b][m][n]); acc[a][b][m][n] = (f32x4){(float)t_[0], (float)t_[1], (float)t_[2], (float)t_[3]}; }
            if constexpr (Epi::COLSCALE) {
                const float* wp_ = E.wsc + cur.pn * BM + wc * 32 + 8 * fq;
#pragma unroll
                for (int b = 0; b < 2; ++b)
#pragma unroll
                    for (int n = 0; n < 2; ++n) { const f32x4 s_ = *(const f32x4*)(wp_ + b * HALF + 4 * n);
#pragma unroll
                        for (int a = 0; a < 2; ++a)
#pragma unroll
                            for (int m = 0; m < 4; ++m) acc[a][b][m][n] *= s_; } } }
        if constexpr (!Epi::AFTER_DRAIN) { E(acc, cur, wr, wc, fr, fq); S.done(cur); }
        if (!has_next) break;
#pragma unroll
        for (int a = 0; a < 2; ++a)
#pragma unroll
            for (int b = 0; b < 2; ++b)
#pragma unroll
                for (int m = 0; m < 4; ++m)
#pragma unroll
                    for (int n = 0; n < 2; ++n) acc[a][b][m][n] = (f32x4){0.f, 0.f, 0.f, 0.f};
        cur = nxt; cA = nA; cB = nB; ++ui;
        if constexpr (ALIGN_EPI) { if (wr == 1) PG8_BAR; }
    }
    PG8_WAIT_V(0);
    if constexpr (!ALIGN_EPI) { if (wr == 0) PG8_BAR; }
    PG8_BAR;
    if constexpr (Epi::AFTER_DRAIN) { E.fused(acc, cur, wr, wc, fr, fq, lds, wid, lane); S.done(cur); }
#undef PG8_SA
#undef PG8_SB
#undef PG8_STAGE
#undef PG8_LDA
#undef PG8_LDB
#undef PG8_MMA
#undef PG8_WAIT_V
#undef PG8_WAIT_L
#undef PG8_BAR
#undef PG8_SCHED
}
}
namespace att {
#define ATT_LAS __attribute__((address_space(3)))
typedef unsigned short bf16_t;
using bf16x8 = __attribute__((ext_vector_type(8))) short;
using s16x4  = __attribute__((ext_vector_type(4))) short;
using f32x16 = __attribute__((ext_vector_type(16))) float;
using u32x4  = __attribute__((ext_vector_type(4))) unsigned;
constexpr int   D = 128, NW = 8, QBLK = 32, KVBLK = 64;
constexpr float SCALE = 0.088388347648318440f, LOG2E = 1.4426950408889634f;
constexpr float THR = 8.f;
constexpr int SHM_V = KVBLK * D * 2, SHM_K = KVBLK * D * 2;
constexpr int OFF_WS = 2 * SHM_V + 2 * SHM_K;
constexpr int OFF_TAB = OFF_WS + NW * 64 * 4;
constexpr int SHM_ATTN = OFF_TAB + 640 * 4;
constexpr float NEG = -1e30f;
#define KSWZ(row, colB) ((row) * 256 + ((colB) ^ (((row) & 7) << 4)))
#define SBAR() __builtin_amdgcn_sched_barrier(0)
__device__ __forceinline__ int crow(int r, int hi) { return (r & 3) + 8 * (r >> 2) + 4 * hi; }
__device__ __forceinline__ unsigned cvtpk(float lo, float hi) { unsigned r; asm volatile("v_cvt_pk_bf16_f32 %0, %1, %2" : "=v"(r) : "v"(lo), "v"(hi)); return r; }

template <bool LOG2>
__device__ __forceinline__ void partialSM(f32x16& p0, f32x16& p1, float& m_reg, float& mn, float& alpha) {
  constexpr float C = LOG2 ? 1.0f : SCALE * LOG2E;
  constexpr float TH = LOG2 ? THR * LOG2E : THR / SCALE;
  float pmax = p0[0];
#pragma unroll
  for (int r = 1; r < 16; ++r) pmax = fmaxf(pmax, p0[r]);
#pragma unroll
  for (int r = 0; r < 16; ++r) pmax = fmaxf(pmax, p1[r]);
  { auto rr = __builtin_amdgcn_permlane32_swap(__float_as_uint(pmax), __float_as_uint(pmax), false, false);
    pmax = fmaxf(__uint_as_float(rr[0]), __uint_as_float(rr[1])); }
  if (__builtin_expect(__all(pmax - m_reg <= TH), 1)) { mn = m_reg; alpha = 1.f; }
  else { mn = fmaxf(m_reg, pmax); alpha = __builtin_amdgcn_exp2f((m_reg - mn) * C); m_reg = mn; }
  float mnC = -mn * C;
#pragma unroll
  for (int r = 0; r < 16; ++r) p0[r] = fmaf(p0[r], C, mnC);
#pragma unroll
  for (int r = 0; r < 16; ++r) p1[r] = fmaf(p1[r], C, mnC);
#pragma unroll
  for (int r = 0; r < 16; ++r) p0[r] = __builtin_amdgcn_exp2f(p0[r]);
}
template <bool NOEXP = false>
__device__ __forceinline__ void finishSM(f32x16& p0, f32x16& p1, float alpha, float& l_reg, bf16x8& pa0, bf16x8& pa1, bf16x8& pa2, bf16x8& pa3) {
  if constexpr (!NOEXP) {
#pragma unroll
    for (int r = 0; r < 16; ++r) p1[r] = __builtin_amdgcn_exp2f(p1[r]); }
  typedef float f32x2_t __attribute__((ext_vector_type(2)));
  f32x2_t ps2 = {0.f, 0.f};
#pragma unroll
  for (int r = 0; r < 16; r += 2) ps2 += (f32x2_t){p0[r], p0[r + 1]};
#pragma unroll
  for (int r = 0; r < 16; r += 2) ps2 += (f32x2_t){p1[r], p1[r + 1]};
  float ps = ps2[0] + ps2[1];
  { auto rr = __builtin_amdgcn_permlane32_swap(__float_as_uint(ps), __float_as_uint(ps), false, false);
    ps = __uint_as_float(rr[0]) + __uint_as_float(rr[1]); }
  l_reg = l_reg * alpha + ps;
#define PK4(P, BASE, OUT) do { unsigned a0 = cvtpk(P[BASE + 0], P[BASE + 1]), a1 = cvtpk(P[BASE + 2], P[BASE + 3]);   \
    unsigned b0 = cvtpk(P[BASE + 4], P[BASE + 5]), b1 = cvtpk(P[BASE + 6], P[BASE + 7]);                              \
    auto r0 = __builtin_amdgcn_permlane32_swap(a0, b0, false, false); auto r1 = __builtin_amdgcn_permlane32_swap(a1, b1, false, false); \
    u32x4 w = {r0[0], r1[0], r0[1], r1[1]}; OUT = __builtin_bit_cast(bf16x8, w); } while (0)
  PK4(p0, 0, pa0); PK4(p0, 8, pa1); PK4(p1, 0, pa2); PK4(p1, 8, pa3);
#undef PK4
}
__device__ __forceinline__ void qkt(f32x16& p0, f32x16& p1, const ATT_LAS char* Ks, const bf16x8* qr, int r32, int hi) {
  p0 = f32x16{}; p1 = f32x16{};
  int ka[4];
#pragma unroll
  for (int d = 0; d < 4; ++d) ka[d] = KSWZ(r32, (d * 16 + hi * 8) * 2);
  bf16x8 c0 = *reinterpret_cast<const ATT_LAS bf16x8*>(Ks + ka[0]), c1 = *reinterpret_cast<const ATT_LAS bf16x8*>(Ks + ka[0] + 32 * 256);
#pragma unroll
  for (int d0 = 0; d0 < 8; ++d0) {
    bf16x8 n0 = c0, n1 = c1;
    if (d0 < 7) { n0 = *reinterpret_cast<const ATT_LAS bf16x8*>(Ks + ka[(d0 + 1) & 3] + ((d0 + 1) >> 2) * 128); n1 = *reinterpret_cast<const ATT_LAS bf16x8*>(Ks + ka[(d0 + 1) & 3] + ((d0 + 1) >> 2) * 128 + 32 * 256); }
    asm volatile("" : "+v"(c0), "+v"(c1) :: "memory");
    p0 = __builtin_amdgcn_mfma_f32_32x32x16_bf16(c0, qr[d0], p0, 0, 0, 0);
    p1 = __builtin_amdgcn_mfma_f32_32x32x16_bf16(c1, qr[d0], p1, 0, 0, 0);
    c0 = n0; c1 = n1; }
}
__device__ __forceinline__ void qkt_np(f32x16& p0, f32x16& p1, const ATT_LAS char* Ks, const bf16x8* qr, int r32, int hi) {
  p0 = f32x16{}; p1 = f32x16{};
  int ka[4];
#pragma unroll
  for (int d = 0; d < 4; ++d) ka[d] = KSWZ(r32, (d * 16 + hi * 8) * 2);
#pragma unroll
  for (int d0 = 0; d0 < 8; ++d0) {
    bf16x8 b0 = *reinterpret_cast<const ATT_LAS bf16x8*>(Ks + ka[d0 & 3] + (d0 >> 2) * 128);
    bf16x8 b1 = *reinterpret_cast<const ATT_LAS bf16x8*>(Ks + ka[d0 & 3] + (d0 >> 2) * 128 + 32 * 256);
    p0 = __builtin_amdgcn_mfma_f32_32x32x16_bf16(b0, qr[d0], p0, 0, 0, 0); p1 = __builtin_amdgcn_mfma_f32_32x32x16_bf16(b1, qr[d0], p1, 0, 0, 0); }
}
typedef int v8i_t __attribute__((ext_vector_type(8)));
#define K8SWZ(row, colB) ((row) * 128 + ((colB) ^ ((((row) >> 1) & 7) << 4)))
template <int SB  >
__device__ __forceinline__ void qkt8(f32x16& p0, f32x16& p1, const ATT_LAS char* Ks, const v8i_t* qf, int r32, int hi) {
  p0 = f32x16{}; p1 = f32x16{};
  const int x0 = r32 * 128 + (((2 * hi) ^ ((r32 >> 1) & 7)) << 4);
#pragma unroll
  for (int s = 0; s < 2; ++s) {
    const u32x4 k00 = *reinterpret_cast<const ATT_LAS u32x4*>(Ks + (x0 ^ (64 * s))), k01 = *reinterpret_cast<const ATT_LAS u32x4*>(Ks + (x0 ^ (64 * s) ^ 16));
    const u32x4 k10 = *reinterpret_cast<const ATT_LAS u32x4*>(Ks + (x0 ^ (64 * s)) + 4096), k11 = *reinterpret_cast<const ATT_LAS u32x4*>(Ks + (x0 ^ (64 * s) ^ 16) + 4096);
    const v8i_t ka = {(int)k00.x, (int)k00.y, (int)k00.z, (int)k00.w, (int)k01.x, (int)k01.y, (int)k01.z, (int)k01.w}, kb = {(int)k10.x, (int)k10.y, (int)k10.z, (int)k10.w, (int)k11.x, (int)k11.y, (int)k11.z, (int)k11.w};
    p0 = __builtin_amdgcn_mfma_scale_f32_32x32x64_f8f6f4(ka, qf[s], p0, 0, 0, 0, 0x7F7F7F7F, 0, SB);
    p1 = __builtin_amdgcn_mfma_scale_f32_32x32x64_f8f6f4(kb, qf[s], p1, 0, 0, 0, 0x7F7F7F7F, 0, SB); }
}
__device__ __forceinline__ void qkt_shift(f32x16& p0, f32x16& p1, const ATT_LAS char* Ks, const bf16x8* qr, const f32x16& negm, int r32, int hi) {
  int ka[4];
#pragma unroll
  for (int d = 0; d < 4; ++d) ka[d] = KSWZ(r32, (d * 16 + hi * 8) * 2);
#pragma unroll
  for (int d0 = 0; d0 < 8; ++d0) {
    bf16x8 b0 = *reinterpret_cast<const ATT_LAS bf16x8*>(Ks + ka[d0 & 3] + (d0 >> 2) * 128);
    bf16x8 b1 = *reinterpret_cast<const ATT_LAS bf16x8*>(Ks + ka[d0 & 3] + (d0 >> 2) * 128 + 32 * 256);
    if (d0 == 0) { p0 = __builtin_amdgcn_mfma_f32_32x32x16_bf16(b0, qr[d0], negm, 0, 0, 0); p1 = __builtin_amdgcn_mfma_f32_32x32x16_bf16(b1, qr[d0], negm, 0, 0, 0); }
    else { p0 = __builtin_amdgcn_mfma_f32_32x32x16_bf16(b0, qr[d0], p0, 0, 0, 0); p1 = __builtin_amdgcn_mfma_f32_32x32x16_bf16(b1, qr[d0], p1, 0, 0, 0); } }
}
__device__ __forceinline__ void partialSM_shift(f32x16& p0, f32x16& p1, float& m_reg, f32x16& negm, float& alpha, const bool fixed) {
  constexpr float TH = THR * LOG2E;
  alpha = 1.f;
  if (!fixed) {
    float pmax = p0[0];
#pragma unroll
    for (int r = 1; r < 16; ++r) pmax = fmaxf(pmax, p0[r]);
#pragma unroll
    for (int r = 0; r < 16; ++r) pmax = fmaxf(pmax, p1[r]);
    { auto rr = __builtin_amdgcn_permlane32_swap(__float_as_uint(pmax), __float_as_uint(pmax), false, false);
      pmax = fmaxf(__uint_as_float(rr[0]), __uint_as_float(rr[1])); }
    if (!__builtin_expect(__all(pmax <= TH), 1)) { const float d = fmaxf(pmax, 0.f); alpha = __builtin_amdgcn_exp2f(-d); m_reg += d;
#pragma unroll
      for (int r = 0; r < 16; ++r) { p0[r] -= d; p1[r] -= d; negm[r] = -m_reg; } }
  }
#pragma unroll
  for (int r = 0; r < 16; ++r) p0[r] = __builtin_amdgcn_exp2f(p0[r]);
}
__device__ __forceinline__ void na_hook(f32x16& p0, f32x16& p1, int kr, int qrow, int rs, int csrel, const ATT_LAS float* tabq) {
  constexpr float C = SCALE * LOG2E;
  const bool rowvalid = (kr >= rs) && (kr < rs + 8);
  if (!rowvalid) {
#pragma unroll
    for (int r = 0; r < 16; ++r) { p0[r] = NEG; p1[r] = NEG; }
  } else {
    const ATT_LAS float* tb = tabq + (kr - qrow + 7) * 32;
#pragma unroll
    for (int r = 0; r < 16; ++r) { const int kc = (r & 3) + 8 * (r >> 2);
      const float b0 = tb[kc], b1 = tb[32 + kc];
      p0[r] = ((unsigned)(kc + csrel) < 16u) ? fmaf(p0[r], C, b0) : NEG;
      p1[r] = ((unsigned)(kc + 32 + csrel) < 16u) ? fmaf(p1[r], C, b1) : NEG; }
  }
}
__device__ __forceinline__ int v_st(int k, int c) { const int kk = (k & ~0xC) | ((k & 4) << 1) | ((k & 8) >> 1); return ((kk >> 3) * 4 + (c >> 5)) * 512 + ((kk & 7) * 32 + (c & 31)) * 2; }
__device__ __forceinline__ int v_rd_base(int lane) { return ((lane & 3) << 3) | (((lane >> 2) & 3) << 6) | (((lane >> 4) & 1) << 5) | (((lane >> 5) & 1) << 8); }
constexpr int v_rd_off(int d0, int ks, int half) { return d0 * 512 + ks * 4096 + half * 2048; }
template <int OFF> __device__ __forceinline__ s16x4 tr_read(int vb) {
  s16x4 r; asm volatile("ds_read_b64_tr_b16 %0, %1 offset:%2" : "=&v"(r) : "v"(vb), "i"(OFF) : "memory"); return r;
}
template <int D0> __device__ __forceinline__ void pv_one(f32x16& od, int vb, bf16x8 pa0, bf16x8 pa1, bf16x8 pa2, bf16x8 pa3) {
  const s16x4 l0 = tr_read<v_rd_off(D0, 0, 0)>(vb), h0 = tr_read<v_rd_off(D0, 0, 1)>(vb), l1 = tr_read<v_rd_off(D0, 1, 0)>(vb), h1 = tr_read<v_rd_off(D0, 1, 1)>(vb);
  const s16x4 l2 = tr_read<v_rd_off(D0, 2, 0)>(vb), h2 = tr_read<v_rd_off(D0, 2, 1)>(vb), l3 = tr_read<v_rd_off(D0, 3, 0)>(vb), h3 = tr_read<v_rd_off(D0, 3, 1)>(vb);
#ifdef ATT_PROBE_LDS
  { const s16x4 x0 = tr_read<v_rd_off(D0, 0, 0)>(vb), x1 = tr_read<v_rd_off(D0, 0, 1)>(vb), x2 = tr_read<v_rd_off(D0, 1, 0)>(vb), x3 = tr_read<v_rd_off(D0, 1, 1)>(vb);
    const s16x4 x4 = tr_read<v_rd_off(D0, 2, 0)>(vb), x5 = tr_read<v_rd_off(D0, 2, 1)>(vb), x6 = tr_read<v_rd_off(D0, 3, 0)>(vb), x7 = tr_read<v_rd_off(D0, 3, 1)>(vb);
    asm volatile("" :: "v"(x0), "v"(x1), "v"(x2), "v"(x3), "v"(x4), "v"(x5), "v"(x6), "v"(x7)); }
#endif
  asm volatile("s_waitcnt lgkmcnt(0)" ::: "memory"); SBAR();
#define PK(L, H) (bf16x8){L[0], L[1], L[2], L[3], H[0], H[1], H[2], H[3]}
#ifdef ATT_PROBE_VALU
#define PVX() do { _Pragma("unroll") for (int i_ = 0; i_ < ATT_PROBE_VALU; ++i_) asm volatile("v_exp_f32 %0, %0" : "+v"(dmy_)); } while (0)
  float dmy_ = 1.0f;
#else
#define PVX() do { } while (0)
#endif
  od = __builtin_amdgcn_mfma_f32_32x32x16_bf16(pa0, PK(l0, h0), od, 0, 0, 0); PVX();
  od = __builtin_amdgcn_mfma_f32_32x32x16_bf16(pa1, PK(l1, h1), od, 0, 0, 0); PVX();
  od = __builtin_amdgcn_mfma_f32_32x32x16_bf16(pa2, PK(l2, h2), od, 0, 0, 0); PVX();
  od = __builtin_amdgcn_mfma_f32_32x32x16_bf16(pa3, PK(l3, h3), od, 0, 0, 0); PVX();
#undef PVX
#ifdef ATT_PROBE_MFMA
  { const bf16x8 z8 = {0, 0, 0, 0, 0, 0, 0, 0}; od = __builtin_amdgcn_mfma_f32_32x32x16_bf16(z8, PK(l0, h0), od, 0, 0, 0); od = __builtin_amdgcn_mfma_f32_32x32x16_bf16(z8, PK(l1, h1), od, 0, 0, 0);
    od = __builtin_amdgcn_mfma_f32_32x32x16_bf16(z8, PK(l2, h2), od, 0, 0, 0); od = __builtin_amdgcn_mfma_f32_32x32x16_bf16(z8, PK(l3, h3), od, 0, 0, 0); }
#endif
#undef PK
}
#ifndef PV_PREFETCH
#define PV_PREFETCH 0
#endif
struct VFrag { s16x4 l0, h0, l1, h1, l2, h2, l3, h3; };
template <int D0> __device__ __forceinline__ void pv_read(VFrag& f, int vb) {
  f.l0 = tr_read<v_rd_off(D0, 0, 0)>(vb); f.h0 = tr_read<v_rd_off(D0, 0, 1)>(vb); f.l1 = tr_read<v_rd_off(D0, 1, 0)>(vb); f.h1 = tr_read<v_rd_off(D0, 1, 1)>(vb);
  f.l2 = tr_read<v_rd_off(D0, 2, 0)>(vb); f.h2 = tr_read<v_rd_off(D0, 2, 1)>(vb); f.l3 = tr_read<v_rd_off(D0, 3, 0)>(vb); f.h3 = tr_read<v_rd_off(D0, 3, 1)>(vb);
}
__device__ __forceinline__ void pv_mma(f32x16& od, const VFrag& f, bf16x8 pa0, bf16x8 pa1, bf16x8 pa2, bf16x8 pa3) {
#define PK(L, H) (bf16x8){L[0], L[1], L[2], L[3], H[0], H[1], H[2], H[3]}
  od = __builtin_amdgcn_mfma_f32_32x32x16_bf16(pa0, PK(f.l0, f.h0), od, 0, 0, 0);
  od = __builtin_amdgcn_mfma_f32_32x32x16_bf16(pa1, PK(f.l1, f.h1), od, 0, 0, 0);
  od = __builtin_amdgcn_mfma_f32_32x32x16_bf16(pa2, PK(f.l2, f.h2), od, 0, 0, 0);
  od = __builtin_amdgcn_mfma_f32_32x32x16_bf16(pa3, PK(f.l3, f.h3), od, 0, 0, 0);
#undef PK
}
#ifndef EXPV
#define EXPV 0
#endif
template <int NE, int D0> __device__ __forceinline__ void pv_exp_one(f32x16& od, int vb, bf16x8 pa0, bf16x8 pa1, bf16x8 pa2, bf16x8 pa3, f32x16& s0, f32x16& s1) {
  const s16x4 l0 = tr_read<v_rd_off(D0, 0, 0)>(vb), h0 = tr_read<v_rd_off(D0, 0, 1)>(vb), l1 = tr_read<v_rd_off(D0, 1, 0)>(vb), h1 = tr_read<v_rd_off(D0, 1, 1)>(vb);
  const s16x4 l2 = tr_read<v_rd_off(D0, 2, 0)>(vb), h2 = tr_read<v_rd_off(D0, 2, 1)>(vb), l3 = tr_read<v_rd_off(D0, 3, 0)>(vb), h3 = tr_read<v_rd_off(D0, 3, 1)>(vb);
  asm volatile("s_waitcnt lgkmcnt(0)" ::: "memory"); SBAR();
#define PK(L, H) (bf16x8){L[0], L[1], L[2], L[3], H[0], H[1], H[2], H[3]}
#define EX(i) do { asm volatile("v_exp_f32 %0, %0" : "+v"(s0[D0 * 4 + i])); if constexpr (NE == 32) asm volatile("v_exp_f32 %0, %0" : "+v"(s1[D0 * 4 + i])); } while (0)
  od = __builtin_amdgcn_mfma_f32_32x32x16_bf16(pa0, PK(l0, h0), od, 0, 0, 0); EX(0);
  od = __builtin_amdgcn_mfma_f32_32x32x16_bf16(pa1, PK(l1, h1), od, 0, 0, 0); EX(1);
  od = __builtin_amdgcn_mfma_f32_32x32x16_bf16(pa2, PK(l2, h2), od, 0, 0, 0); EX(2);
  od = __builtin_amdgcn_mfma_f32_32x32x16_bf16(pa3, PK(l3, h3), od, 0, 0, 0); EX(3);
#undef EX
#undef PK
}
template <int NE> __device__ __forceinline__ void pv_exp(f32x16* o, int vb, bf16x8 pa0, bf16x8 pa1, bf16x8 pa2, bf16x8 pa3, f32x16& s0, f32x16& s1) {
  pv_exp_one<NE, 0>(o[0], vb, pa0, pa1, pa2, pa3, s0, s1); pv_exp_one<NE, 1>(o[1], vb, pa0, pa1, pa2, pa3, s0, s1);
  pv_exp_one<NE, 2>(o[2], vb, pa0, pa1, pa2, pa3, s0, s1); pv_exp_one<NE, 3>(o[3], vb, pa0, pa1, pa2, pa3, s0, s1);
}
template <bool PF> __device__ __forceinline__ void pv_d0(f32x16* o, int vb, bf16x8 pa0, bf16x8 pa1, bf16x8 pa2, bf16x8 pa3) {
  if constexpr (PF) {
  VFrag fa, fb;
  pv_read<0>(fa, vb);
  pv_read<1>(fb, vb); asm volatile("s_waitcnt lgkmcnt(8)" ::: "memory"); SBAR(); pv_mma(o[0], fa, pa0, pa1, pa2, pa3); SBAR();
  pv_read<2>(fa, vb); asm volatile("s_waitcnt lgkmcnt(8)" ::: "memory"); SBAR(); pv_mma(o[1], fb, pa0, pa1, pa2, pa3); SBAR();
  pv_read<3>(fb, vb); asm volatile("s_waitcnt lgkmcnt(8)" ::: "memory"); SBAR(); pv_mma(o[2], fa, pa0, pa1, pa2, pa3); SBAR();
  asm volatile("s_waitcnt lgkmcnt(0)" ::: "memory"); SBAR(); pv_mma(o[3], fb, pa0, pa1, pa2, pa3);
  } else {
  pv_one<0>(o[0], vb, pa0, pa1, pa2, pa3); pv_one<1>(o[1], vb, pa0, pa1, pa2, pa3); pv_one<2>(o[2], vb, pa0, pa1, pa2, pa3); pv_one<3>(o[3], vb, pa0, pa1, pa2, pa3); }
}

__device__ __forceinline__ void psm8(f32x16& p0, f32x16& p1, float& e0, float& e1, const int hi) {
  float m0 = p0[0], m1 = p1[0];
#pragma unroll
  for (int r = 1; r < 15; r += 2) { m0 = __builtin_fmaxf(__builtin_fmaxf(m0, p0[r]), p0[r + 1]); m1 = __builtin_fmaxf(__builtin_fmaxf(m1, p1[r]), p1[r + 1]); }
  float M = fmaxf(fmaxf(m0, p0[15]), fmaxf(m1, p1[15]));
  { const auto rr = __builtin_amdgcn_permlane32_swap(__float_as_uint(M), __float_as_uint(M), false, false); M = fmaxf(__uint_as_float(rr[0]), __uint_as_float(rr[1])); }
  e0 = e1 = __builtin_ceilf(M) - 7.0f;
#pragma unroll
  for (int r = 0; r < 16; ++r) p0[r] = __builtin_amdgcn_exp2f(p0[r]);
}
#ifndef CVT_DIV
#define CVT_DIV 1
#endif
__device__ __forceinline__ void fsm8(f32x16& p0, f32x16& p1, const float e0, const float e1, float& l_reg, v8i_t& pf, int& psc, const int hi) {
#pragma unroll
  for (int r = 0; r < 16; ++r) p1[r] = __builtin_amdgcn_exp2f(p1[r]);
  typedef short v2s_t __attribute__((ext_vector_type(2)));
  const int eb = (int)e0 + 127;
  const float sc = __uint_as_float((unsigned)(CVT_DIV ? eb : 254 - eb) << 23);
#pragma unroll
  for (int g = 0; g < 4; ++g) { v2s_t a0 = {0, 0}, a1 = {0, 0};
    a0 = __builtin_amdgcn_cvt_scalef32_pk_fp8_f32(a0, p0[4 * g], p0[4 * g + 1], sc, false); a0 = __builtin_amdgcn_cvt_scalef32_pk_fp8_f32(a0, p0[4 * g + 2], p0[4 * g + 3], sc, true);
    a1 = __builtin_amdgcn_cvt_scalef32_pk_fp8_f32(a1, p1[4 * g], p1[4 * g + 1], sc, false); a1 = __builtin_amdgcn_cvt_scalef32_pk_fp8_f32(a1, p1[4 * g + 2], p1[4 * g + 3], sc, true);
    const auto rr = __builtin_amdgcn_permlane32_swap(__builtin_bit_cast(unsigned, a0), __builtin_bit_cast(unsigned, a1), false, false);
    pf[2 * g] = (int)rr[0]; pf[2 * g + 1] = (int)rr[1]; }
  psc = eb | (eb << 8) | (eb << 16) | (eb << 24);
}
__device__ __forceinline__ void pv8(f32x16* o, f32x16& lacc, const ATT_LAS char* Vt, const v8i_t pf, const int psc, const int r32, const int hi) {
#ifdef ONES_LIVE
  { const v8i_t ones = {0x38383838, 0x38383838, 0x38383838, 0x38383838, 0x38383838, 0x38383838, 0x38383838, 0x38383838};
#else
  { int o1_ = 0x38383838; asm volatile("" : "+v"(o1_));            const v8i_t ones = {o1_, o1_, o1_, o1_, o1_, o1_, o1_, o1_};
#endif
    lacc = __builtin_amdgcn_mfma_scale_f32_32x32x64_f8f6f4(pf, ones, lacc, 0, 0, 0, psc, 0, 0x7F7F7F7F); }
  const int a0 = r32 * 64 + (((2 * hi) ^ ((r32 >> 2) & 3)) << 4);
#pragma unroll
  for (int cb = 0; cb < 4; ++cb) {
    const u32x4 x = *reinterpret_cast<const ATT_LAS u32x4*>(Vt + cb * 2048 + a0), y = *reinterpret_cast<const ATT_LAS u32x4*>(Vt + cb * 2048 + (a0 ^ 16));
    const v8i_t vf = {(int)x.x, (int)x.y, (int)x.z, (int)x.w, (int)y.x, (int)y.y, (int)y.z, (int)y.w};
    o[cb] = __builtin_amdgcn_mfma_scale_f32_32x32x64_f8f6f4(pf, vf, o[cb], 0, 0, 0, psc, 0, 0x7F7F7F7F); }
}

#ifndef ILV8
#define ILV8 1
#endif
__device__ __forceinline__ void step8(f32x16* o, f32x16& lacc, f32x16& a0, f32x16& a1, const float ea, f32x16& b0, f32x16& b1, float& eb,
                                      const ATT_LAS char* Ks, const ATT_LAS char* Vt, const v8i_t* qf, v8i_t& pf, const int r32, const int hi) {
  typedef short v2s_t __attribute__((ext_vector_type(2)));
  const int x0 = r32 * 128 + (((2 * hi) ^ ((r32 >> 1) & 7)) << 4);
  const int va = r32 * 64 + (((2 * hi) ^ ((r32 >> 2) & 3)) << 4);
  const int ebi = (int)ea + 127; const float sc = __uint_as_float((unsigned)ebi << 23); const int psc = ebi | (ebi << 8) | (ebi << 16) | (ebi << 24);
  const f32x16 zero = {};
#define S8_LDK(s, KA, KB) do { const u32x4 k00 = *reinterpret_cast<const ATT_LAS u32x4*>(Ks + (x0 ^ (64 * (s)))), k01 = *reinterpret_cast<const ATT_LAS u32x4*>(Ks + (x0 ^ (64 * (s)) ^ 16)); \
    const u32x4 k10 = *reinterpret_cast<const ATT_LAS u32x4*>(Ks + (x0 ^ (64 * (s))) + 4096), k11 = *reinterpret_cast<const ATT_LAS u32x4*>(Ks + (x0 ^ (64 * (s)) ^ 16) + 4096); \
    KA = (v8i_t){(int)k00.x, (int)k00.y, (int)k00.z, (int)k00.w, (int)k01.x, (int)k01.y, (int)k01.z, (int)k01.w}; KB = (v8i_t){(int)k10.x, (int)k10.y, (int)k10.z, (int)k10.w, (int)k11.x, (int)k11.y, (int)k11.z, (int)k11.w}; } while (0)
#define S8_LDV(cb, VF) do { const u32x4 x_ = *reinterpret_cast<const ATT_LAS u32x4*>(Vt + (cb) * 2048 + va), y_ = *reinterpret_cast<const ATT_LAS u32x4*>(Vt + (cb) * 2048 + (va ^ 16)); \
    VF = (v8i_t){(int)x_.x, (int)x_.y, (int)x_.z, (int)x_.w, (int)y_.x, (int)y_.y, (int)y_.z, (int)y_.w}; } while (0)
#define S8_PACK(g) do { v2s_t c0_ = __builtin_bit_cast(v2s_t, pf[2 * (g)]), c1_ = __builtin_bit_cast(v2s_t, pf[2 * (g) + 1]); \
    c0_ = __builtin_amdgcn_cvt_scalef32_pk_fp8_f32(c0_, a0[4 * (g)], a0[4 * (g) + 1], sc, false); c0_ = __builtin_amdgcn_cvt_scalef32_pk_fp8_f32(c0_, a0[4 * (g) + 2], a0[4 * (g) + 3], sc, true); \
    c1_ = __builtin_amdgcn_cvt_scalef32_pk_fp8_f32(c1_, a1[4 * (g)], a1[4 * (g) + 1], sc, false); c1_ = __builtin_amdgcn_cvt_scalef32_pk_fp8_f32(c1_, a1[4 * (g) + 2], a1[4 * (g) + 3], sc, true); \
    const auto rr_ = __builtin_amdgcn_permlane32_swap(__builtin_bit_cast(unsigned, c0_), __builtin_bit_cast(unsigned, c1_), false, false); pf[2 * (g)] = (int)rr_[0]; pf[2 * (g) + 1] = (int)rr_[1]; } while (0)
#define S8_QK(KX, s, ACC) __builtin_amdgcn_mfma_scale_f32_32x32x64_f8f6f4(KX, qf[s], ACC, 0, 0, 0, 0x7F7F7F7F, 0, 0x7C7C7C7C)
  v8i_t ka, kb, vf;
  S8_LDK(0, ka, kb);
  b0 = S8_QK(ka, 0, zero); SBAR();
#pragma unroll
  for (int r = 0; r < 8; ++r) a1[r] = __builtin_amdgcn_exp2f(a1[r]);
  SBAR();
  b1 = S8_QK(kb, 0, zero); SBAR();
  S8_LDK(1, ka, kb);
#pragma unroll
  for (int r = 8; r < 16; ++r) a1[r] = __builtin_amdgcn_exp2f(a1[r]);
  SBAR();
  b0 = S8_QK(ka, 1, b0); SBAR();
  S8_PACK(0); S8_PACK(1); SBAR();
  b1 = S8_QK(kb, 1, b1); SBAR();
  S8_PACK(2); S8_PACK(3);
  int o1_ = 0x38383838; asm volatile("" : "+v"(o1_)); const v8i_t ones = {o1_, o1_, o1_, o1_, o1_, o1_, o1_, o1_};
  S8_LDV(0, vf); SBAR();
  lacc = __builtin_amdgcn_mfma_scale_f32_32x32x64_f8f6f4(pf, ones, lacc, 0, 0, 0, psc, 0, 0x7F7F7F7F); SBAR();
  float m0 = b0[0];
#pragma unroll
  for (int r = 1; r < 15; r += 2) m0 = __builtin_fmaxf(__builtin_fmaxf(m0, b0[r]), b0[r + 1]);
  m0 = fmaxf(m0, b0[15]); SBAR();
  o[0] = __builtin_amdgcn_mfma_scale_f32_32x32x64_f8f6f4(pf, vf, o[0], 0, 0, 0, psc, 0, 0x7F7F7F7F); SBAR();
  S8_LDV(1, vf);
  float m1 = b1[0];
#pragma unroll
  for (int r = 1; r < 15; r += 2) m1 = __builtin_fmaxf(__builtin_fmaxf(m1, b1[r]), b1[r + 1]);
  float M = fmaxf(m0, fmaxf(m1, b1[15]));
  { const auto rr = __builtin_amdgcn_permlane32_swap(__float_as_uint(M), __float_as_uint(M), false, false); M = fmaxf(__uint_as_float(rr[0]), __uint_as_float(rr[1])); }
  eb = __builtin_ceilf(M) - 7.0f; SBAR();
  o[1] = __builtin_amdgcn_mfma_scale_f32_32x32x64_f8f6f4(pf, vf, o[1], 0, 0, 0, psc, 0, 0x7F7F7F7F); SBAR();
  S8_LDV(2, vf);
#pragma unroll
  for (int r = 0; r < 8; ++r) b0[r] = __builtin_amdgcn_exp2f(b0[r]);
  SBAR();
  o[2] = __builtin_amdgcn_mfma_scale_f32_32x32x64_f8f6f4(pf, vf, o[2], 0, 0, 0, psc, 0, 0x7F7F7F7F); SBAR();
  S8_LDV(3, vf);
#pragma unroll
  for (int r = 8; r < 16; ++r) b0[r] = __builtin_amdgcn_exp2f(b0[r]);
  SBAR();
  o[3] = __builtin_amdgcn_mfma_scale_f32_32x32x64_f8f6f4(pf, vf, o[3], 0, 0, 0, psc, 0, 0x7F7F7F7F);
#undef S8_LDK
#undef S8_LDV
#undef S8_PACK
#undef S8_QK
}

template <bool NA, bool FIXED, int SDEPTH, int LDQ, int LDK, int LDO, bool K8 = false, int LDK8 = 128  , bool O8 = false  , bool V8 = false  , int LDV8 = 8192>
__device__ __forceinline__ void attn_unit(const bf16_t* __restrict__ Qb, const bf16_t* __restrict__ Kb, const bf16_t* __restrict__ Vb, bf16_t* __restrict__ Ob,
                                          int NT, int krow0, int r0, const float* __restrict__ rpb, const float* __restrict__ qg, const float* __restrict__ ropet, int qtok0, const float kmax  , ATT_LAS char* lds, const int wave) {
  int tid_ = wave * 64 + lane_id(); asm volatile("" : "+v"(tid_));
  const int tid = tid_, wid = __builtin_amdgcn_readfirstlane(tid >> 6), lane = tid & 63, r32 = lane & 31, hi = lane >> 5;
  ATT_LAS char* V_lds = lds; ATT_LAS char* K_lds = lds + 2 * SHM_V;
  ATT_LAS float* ws = (ATT_LAS float*)(lds + OFF_WS) + wid * 64; ATT_LAS float* li_l = ws; ATT_LAS float* al_l = ws + 32;
  ATT_LAS float* tab = (ATT_LAS float*)(lds + OFF_TAB);
  __syncthreads();
#ifndef ATT_PRIO
#define ATT_PRIO 1
#endif
#if ATT_PRIO
#ifndef ATT_PRIO_HALF
#define ATT_PRIO_HALF 0
#endif
  if (ATT_PRIO_HALF ? (wid < 4) : (wid >= 4)) __builtin_amdgcn_s_setprio(ATT_PRIO);
#endif
  const int qrow = r0 + (wid >> 1), qc = (wid & 1) * 32 + r32;
  const int rs = min(max(qrow - 4, 0), 120), cs = min(max(qc - 8, 0), 48), csrel = 4 * hi - cs;
  const ATT_LAS float* tabq = tab + 64 + 15 - qc + 4 * hi;
  if constexpr (NA) { for (int i = tid; i < 15 * 32; i += 64 * NW) { const int rr = i >> 5, cc = i & 31; tab[64 + i] = (cc < 31) ? rpb[rr * 31 + cc] * LOG2E : 0.f; } }
  float m_reg = NA ? NEG : -64.0f, l_reg = 0; f32x16 o[4] = {}; bf16x8 qr[8];
  f32x16 negm; if constexpr (!NA) {
#pragma unroll
    for (int r = 0; r < 16; ++r) negm[r] = 64.0f; }
#define QP(d0) (K8 ? 64 * ((d0) >> 2) + 32 * hi + 8 * ((d0) & 3) : (d0) * 16 + hi * 8)
  const bf16_t* Qw = Qb + (long)(wid * QBLK + r32) * LDQ;
#pragma unroll
  for (int d0 = 0; d0 < 8; ++d0) qr[d0] = *reinterpret_cast<const bf16x8*>(Qw + QP(d0));
  v8i_t qf[2];
  if constexpr (!NA) {
    typedef float f32x4_t __attribute__((ext_vector_type(4)));
    float xv[8][8]; float ss = 0.f;
#pragma unroll
    for (int d0 = 0; d0 < 8; ++d0) { const u32x4 w = __builtin_bit_cast(u32x4, qr[d0]);
      xv[d0][0] = __uint_as_float(w.x << 16); xv[d0][1] = __uint_as_float(w.x & 0xffff0000u); xv[d0][2] = __uint_as_float(w.y << 16); xv[d0][3] = __uint_as_float(w.y & 0xffff0000u);
      xv[d0][4] = __uint_as_float(w.z << 16); xv[d0][5] = __uint_as_float(w.z & 0xffff0000u); xv[d0][6] = __uint_as_float(w.w << 16); xv[d0][7] = __uint_as_float(w.w & 0xffff0000u);
#pragma unroll
      for (int j = 0; j < 8; ++j) ss += xv[d0][j] * xv[d0][j]; }
    { auto rr = __builtin_amdgcn_permlane32_swap(__float_as_uint(ss), __float_as_uint(ss), false, false); ss = __uint_as_float(rr[0]) + __uint_as_float(rr[1]); }
    const float rstd = __builtin_amdgcn_rsqf(ss * (1.0f / 128.0f) + 1e-6f);
    const int tq = qtok0 + wid * QBLK + r32;
    constexpr float QS = K8 ? SCALE * LOG2E * 8.0f : SCALE * LOG2E;
#pragma unroll
    for (int d0 = 0; d0 < 8; ++d0) { const int qp = QP(d0), half = K8 ? (d0 >> 2) : (d0 >> 2), i0 = (qp & 63) >> 1; const int pos = half == 0 ? (tq >> 6) : 128 + (tq & 63);
      const f32x4_t gA = *(const f32x4_t*)(qg + 64 * half + i0), gB = *(const f32x4_t*)(qg + 64 * half + 32 + i0);
      const float* cs = ropet + ((size_t)pos * 32 + i0) * 2; const f32x4_t c0 = *(const f32x4_t*)(cs), c1 = *(const f32x4_t*)(cs + 4);
      const float cc[4] = {c0[0], c0[2], c1[0], c1[2]}, sn[4] = {c0[1], c0[3], c1[1], c1[3]};
#pragma unroll
      for (int t = 0; t < 4; ++t) { const float x1 = xv[d0][2 * t] * rstd * gA[t], x2 = xv[d0][2 * t + 1] * rstd * gB[t];
        xv[d0][2 * t] = (x1 * cc[t] - x2 * sn[t]) * QS; xv[d0][2 * t + 1] = (x1 * sn[t] + x2 * cc[t]) * QS; } }
    if constexpr (K8) {
#pragma unroll
      for (int d0 = 0; d0 < 8; ++d0) { int w0 = 0, w1 = 0;
        w0 = __builtin_amdgcn_cvt_pk_fp8_f32(xv[d0][0], xv[d0][1], w0, false); w0 = __builtin_amdgcn_cvt_pk_fp8_f32(xv[d0][2], xv[d0][3], w0, true);
        w1 = __builtin_amdgcn_cvt_pk_fp8_f32(xv[d0][4], xv[d0][5], w1, false); w1 = __builtin_amdgcn_cvt_pk_fp8_f32(xv[d0][6], xv[d0][7], w1, true);
        qf[d0 >> 2][2 * (d0 & 3)] = w0; qf[d0 >> 2][2 * (d0 & 3) + 1] = w1; }
    } else {
#pragma unroll
    for (int d0 = 0; d0 < 8; ++d0) { u32x4 w = {cvtpk(xv[d0][0], xv[d0][1]), cvtpk(xv[d0][2], xv[d0][3]), cvtpk(xv[d0][4], xv[d0][5]), cvtpk(xv[d0][6], xv[d0][7])}; qr[d0] = __builtin_bit_cast(bf16x8, w); }
    }
  }
  if constexpr (NA && K8) {
#pragma unroll
    for (int d0 = 0; d0 < 8; ++d0) { const u32x4 w = __builtin_bit_cast(u32x4, qr[d0]); int w0 = 0, w1 = 0;
      w0 = __builtin_amdgcn_cvt_pk_fp8_f32(__uint_as_float(w.x << 16), __uint_as_float(w.x & 0xffff0000u), w0, false); w0 = __builtin_amdgcn_cvt_pk_fp8_f32(__uint_as_float(w.y << 16), __uint_as_float(w.y & 0xffff0000u), w0, true);
      w1 = __builtin_amdgcn_cvt_pk_fp8_f32(__uint_as_float(w.z << 16), __uint_as_float(w.z & 0xffff0000u), w1, false); w1 = __builtin_amdgcn_cvt_pk_fp8_f32(__uint_as_float(w.w << 16), __uint_as_float(w.w & 0xffff0000u), w1, true);
      qf[d0 >> 2][2 * (d0 & 3)] = w0; qf[d0 >> 2][2 * (d0 & 3) + 1] = w1; }
  }
#undef QP
  const int sr = tid >> 4, sc = (tid & 15) * 8, vst0 = v_st(sr, sc), vst1 = v_st(32 + sr, sc);
  const int vb0 = (int)(unsigned)(uintptr_t)V_lds + v_rd_base(lane);
  struct { bf16x8 vs0, vs1, ks0, ks1; } sr_[SDEPTH];
#define TILE_TOK(t) (NA ? (min(krow0 + (t), 127) * 64) : ((t) * 64))
  typedef const __attribute__((address_space(1))) char* gcp;
  const unsigned lof0 = (unsigned)(sr * LDK + sc) * 2u, lof1 = lof0 + 32u * LDK * 2u;
  const int v8st = (tid >> 2) * 64 + (((tid & 3) ^ ((tid >> 4) & 3)) << 4);
  const int k8st = K8SWZ(tid >> 3, (tid & 7) * 16);
#define SLOAD(i, t) do { const long tb_ = (long)TILE_TOK(t) * (LDK * 2); gcp kt_ = (gcp)Kb + tb_; gcp vt_ = (gcp)Vb + tb_; \
    if constexpr (V8) { sr_[i].vs0 = *(const __attribute__((address_space(1))) bf16x8*)((gcp)Vb + (long)(tid >> 2) * LDV8 + TILE_TOK(t) + (tid & 3) * 16); } \
    else { sr_[i].vs0 = *(const __attribute__((address_space(1))) bf16x8*)(vt_ + lof0); sr_[i].vs1 = *(const __attribute__((address_space(1))) bf16x8*)(vt_ + lof1); } \
    if constexpr (K8) { sr_[i].ks0 = *(const __attribute__((address_space(1))) bf16x8*)((gcp)Kb + (long)(TILE_TOK(t) + (tid >> 3)) * LDK8 + (tid & 7) * 16); } \
    else { sr_[i].ks0 = *(const __attribute__((address_space(1))) bf16x8*)(kt_ + lof0); sr_[i].ks1 = *(const __attribute__((address_space(1))) bf16x8*)(kt_ + lof1); } } while (0)
#define SWRITE(b, i) do { if constexpr (V8) { *(ATT_LAS bf16x8*)(V_lds + (b) * SHM_V + v8st) = sr_[i].vs0; } else { *(ATT_LAS bf16x8*)(V_lds + (b) * SHM_V + vst0) = sr_[i].vs0;          \
    *(ATT_LAS bf16x8*)(V_lds + (b) * SHM_V + vst1) = sr_[i].vs1; } int kc_ = sc * 2;               \
    if constexpr (K8) { *(ATT_LAS bf16x8*)(K_lds + (b) * SHM_K + k8st) = sr_[i].ks0; } else {    \
    *(ATT_LAS bf16x8*)(K_lds + (b) * SHM_K + KSWZ(sr, kc_)) = sr_[i].ks0;                       \
    *(ATT_LAS bf16x8*)(K_lds + (b) * SHM_K + KSWZ(32 + sr, kc_)) = sr_[i].ks1; } } while (0)
#define SWAIT() do { if constexpr (SDEPTH == 2 && K8 && V8) asm volatile("s_waitcnt vmcnt(2)" ::: "memory"); else if constexpr (SDEPTH == 2 && K8) asm volatile("s_waitcnt vmcnt(3)" ::: "memory"); else if constexpr (SDEPTH == 2) asm volatile("s_waitcnt vmcnt(4)" ::: "memory"); else asm volatile("s_waitcnt vmcnt(0)" ::: "memory"); } while (0)
#define RESC(a) do { if constexpr (NA || !FIXED) if (__any((a) < 1.f)) { if (hi == 0) al_l[r32] = (a); asm volatile("s_waitcnt lgkmcnt(0)" ::: "memory"); \
    _Pragma("unroll") for (int d = 0; d < 4; ++d) _Pragma("unroll") for (int r = 0; r < 16; ++r) o[d][r] *= al_l[crow(r, hi)]; } } while (0)
#define HOOK(P0, P1, t) do { if constexpr (NA) na_hook(P0, P1, krow0 + (t), qrow, rs, csrel, tabq); } while (0)
#define QKT(P0, P1, KS) do { if constexpr (K8) qkt8<NA ? 0x7F7F7F7F : 0x7C7C7C7C>(P0, P1, KS, qf, r32, hi); else if constexpr (NA && NA_SKIP) qkt_np(P0, P1, KS, qr, r32, hi); else if constexpr (NA || FIXED) qkt(P0, P1, KS, qr, r32, hi); else qkt_shift(P0, P1, KS, qr, negm, r32, hi); } while (0)
#define PSM(P0, P1, MN, AL) do { if constexpr (V8) psm8(P0, P1, MN, AL, hi); else if constexpr (NA) partialSM<true>(P0, P1, m_reg, MN, AL); else if constexpr (FIXED) { AL = 1.f; _Pragma("unroll") for (int r_ = 0; r_ < 16; ++r_) P0[r_] = __builtin_amdgcn_exp2f(P0[r_]); } else partialSM_shift(P0, P1, m_reg, negm, AL, false); } while (0)
  constexpr bool PVPF = (PV_PREFETCH & 1) ? (!NA && FIXED) : (PV_PREFETCH & 2) ? NA : (PV_PREFETCH & 4) ? (NA || FIXED) : false;
  constexpr int NEV = (!NA && FIXED) ? EXPV : 0;
#define PVONLY(VB) do { if constexpr (V8) pv8(o, lacc, V_lds + ((VB) - vb0), pf, psc, r32, hi); else pv_d0<PVPF>(o, VB, pa0, pa1, pa2, pa3); } while (0)
#define PVS(VB, P0, P1, t, MN, AL) do { if constexpr (V8) { pv8(o, lacc, V_lds + ((VB) - vb0), pf, psc, r32, hi); psm8(P0, P1, MN, AL, hi); } else if constexpr (NEV != 0) { pv_exp<NEV == 0 ? 16 : NEV>(o, VB, pa0, pa1, pa2, pa3, P0, P1); AL = 1.f; } else { pv_d0<PVPF>(o, VB, pa0, pa1, pa2, pa3); HOOK(P0, P1, t); PSM(P0, P1, MN, AL); } } while (0)
#ifndef NA_SKIP
#define NA_SKIP 0
#endif
#define TV(t) (!(NA && NA_SKIP) || (__builtin_amdgcn_readfirstlane((int)(((krow0 + (t)) >= rs && (krow0 + (t)) < rs + 8))) != 0))
#define FSM(P0, P1, MN, AL) do { if constexpr (V8) fsm8(P0, P1, MN, AL, l_reg, pf, psc, hi); else finishSM<NEV == 32>(P0, P1, AL, l_reg, pa0, pa1, pa2, pa3); } while (0)
  f32x16 pA0, pA1, pB0, pB1; float mnA, mnB, alA, alB; bf16x8 pa0, pa1, pa2, pa3; v8i_t pf; int psc; f32x16 lacc = {};
  constexpr int SE = 0, SO = SDEPTH - 1;
  SLOAD(SE, 0); asm volatile("s_waitcnt vmcnt(0)" ::: "memory"); SWRITE(0, SE); __syncthreads();
  alA = 1.f; if (TV(0)) { QKT(pA0, pA1, K_lds); HOOK(pA0, pA1, 0); PSM(pA0, pA1, mnA, alA); }
  if constexpr (NEV == 32) {
#pragma unroll
    for (int r_ = 0; r_ < 16; ++r_) pA1[r_] = __builtin_amdgcn_exp2f(pA1[r_]); }
  SLOAD(SO, 1); if constexpr (SDEPTH == 2) { if (2 < NT) SLOAD(SE, 2); }
  SWAIT(); SWRITE(1, SO); __syncthreads();
#ifndef ATT_ANTI
#define ATT_ANTI 0
#endif
  constexpr bool ANTI = ATT_ANTI && !NA && FIXED;
  if (!ANTI || wid < 4) {
  for (int j = 1; j + 1 < NT; j += 2) {
    if constexpr (NA && NA_SKIP) {
    const bool v0_ = TV(j - 1), v1_ = TV(j), v2_ = TV(j + 1);
    SBAR(); if (v1_) QKT(pB0, pB1, K_lds + SHM_K);
    if (v0_) FSM(pA0, pA1, mnA, alA); SBAR();
    SLOAD(SO, j + SDEPTH); SBAR();
    if (v0_) PVONLY(vb0); alB = 1.f; if (v1_) { HOOK(pB0, pB1, j); PSM(pB0, pB1, mnB, alB); }
    __syncthreads(); SWAIT(); SWRITE(0, SE);
    RESC(alB); __syncthreads();
    SBAR(); if (v2_) QKT(pA0, pA1, K_lds);
    if (v1_) FSM(pB0, pB1, mnB, alB); SBAR();
    if (SDEPTH == 1 || j + 3 < NT) SLOAD(SE, j + 1 + SDEPTH); SBAR();
    if (v1_) PVONLY(vb0 + SHM_V); alA = 1.f; if (v2_) { HOOK(pA0, pA1, j + 1); PSM(pA0, pA1, mnA, alA); }
    __syncthreads(); SWAIT(); SWRITE(1, SO);
    RESC(alA); __syncthreads();
    } else if constexpr (V8 && !NA && ILV8) {
    SLOAD(SO, j + SDEPTH); SBAR();
    step8(o, lacc, pA0, pA1, mnA, pB0, pB1, mnB, K_lds + SHM_K, V_lds, qf, pf, r32, hi);
    __syncthreads(); SWAIT(); SWRITE(0, SE); __syncthreads();
    if (SDEPTH == 1 || j + 3 < NT) SLOAD(SE, j + 1 + SDEPTH); SBAR();
    step8(o, lacc, pB0, pB1, mnB, pA0, pA1, mnA, K_lds, V_lds + SHM_V, qf, pf, r32, hi);
    __syncthreads(); SWAIT(); SWRITE(1, SO); __syncthreads();
    } else {
    SBAR(); QKT(pB0, pB1, K_lds + SHM_K);
    FSM(pA0, pA1, mnA, alA); SBAR();
    SLOAD(SO, j + SDEPTH); SBAR();
    PVS(vb0, pB0, pB1, j, mnB, alB);
    __syncthreads(); SWAIT(); SWRITE(0, SE);
    RESC(alB); __syncthreads();
    SBAR(); QKT(pA0, pA1, K_lds);
    FSM(pB0, pB1, mnB, alB); SBAR();
    if (SDEPTH == 1 || j + 3 < NT) SLOAD(SE, j + 1 + SDEPTH); SBAR();
    PVS(vb0 + SHM_V, pA0, pA1, j + 1, mnA, alA);
    __syncthreads(); SWAIT(); SWRITE(1, SO);
    RESC(alA); __syncthreads();
    }
  }
  } else {
  for (int j = 1; j + 1 < NT; j += 2) {
    SBAR(); FSM(pA0, pA1, mnA, alA); SBAR();
    SLOAD(SO, j + SDEPTH); SBAR();
    pv_d0<PVPF>(o, vb0, pa0, pa1, pa2, pa3); SBAR();
    qkt_np(pB0, pB1, K_lds + SHM_K, qr, r32, hi); HOOK(pB0, pB1, j); PSM(pB0, pB1, mnB, alB);
    __syncthreads(); SWAIT(); SWRITE(0, SE);
    RESC(alB); __syncthreads();
    SBAR(); FSM(pB0, pB1, mnB, alB); SBAR();
    if (SDEPTH == 1 || j + 3 < NT) SLOAD(SE, j + 1 + SDEPTH); SBAR();
    pv_d0<PVPF>(o, vb0 + SHM_V, pa0, pa1, pa2, pa3); SBAR();
    qkt_np(pA0, pA1, K_lds, qr, r32, hi); HOOK(pA0, pA1, j + 1); PSM(pA0, pA1, mnA, alA);
    __syncthreads(); SWAIT(); SWRITE(1, SO);
    RESC(alA); __syncthreads();
  }
  }
  if constexpr (NA && NA_SKIP) {
  const bool v0_ = TV(NT - 2), v1_ = TV(NT - 1);
  SBAR(); if (v1_) QKT(pB0, pB1, K_lds + SHM_K);
  if (v0_) FSM(pA0, pA1, mnA, alA); SBAR();
  if (v0_) PVONLY(vb0); alB = 1.f; if (v1_) { HOOK(pB0, pB1, NT - 1); PSM(pB0, pB1, mnB, alB); }
  __syncthreads(); RESC(alB);
  if (v1_) { FSM(pB0, pB1, mnB, alB); SBAR(); PVONLY(vb0 + SHM_V); }
  } else if constexpr (NA) {
  FSM(pA0, pA1, mnA, alA); SBAR();
  PVONLY(vb0);
  } else if constexpr (V8 && ILV8) {
  step8(o, lacc, pA0, pA1, mnA, pB0, pB1, mnB, K_lds + SHM_K, V_lds, qf, pf, r32, hi);
  FSM(pB0, pB1, mnB, alB); SBAR();
  PVONLY(vb0 + SHM_V);
  } else {
  SBAR(); QKT(pB0, pB1, K_lds + SHM_K);
  FSM(pA0, pA1, mnA, alA); SBAR();
  PVS(vb0, pB0, pB1, NT - 1, mnB, alB);
  __syncthreads(); RESC(alB);
  FSM(pB0, pB1, mnB, alB); SBAR();
  PVONLY(vb0 + SHM_V);
  }

#if ATT_PRIO
  __builtin_amdgcn_s_setprio(0);
#endif
  if (hi == 0) li_l[r32] = l_reg; asm volatile("s_waitcnt lgkmcnt(0)" ::: "memory");
  float rli[16];
#pragma unroll
  for (int r = 0; r < 16; ++r) rli[r] = __builtin_amdgcn_rcpf(V8 ? lacc[r] : li_l[crow(r, hi)]) * (O8 ? 16.0f : 1.0f);
  bf16_t* Ow = O8 ? (bf16_t*)((unsigned char*)Ob + (long)(wid * QBLK) * LDO) : Ob + (long)(wid * QBLK) * LDO;
#pragma unroll
  for (int r = 0; r < 16; ++r) { const int orow = crow(r, hi);
#pragma unroll
    for (int d0 = 0; d0 < 4; ++d0) { const float v = o[d0][r] * rli[r];
      if constexpr (O8) { int w_ = 0; const float v16 = fminf(fmaxf(v, -448.0f), 448.0f);     w_ = __builtin_amdgcn_cvt_pk_fp8_f32(v16, v16, w_, false); ((unsigned char*)Ow)[(long)orow * LDO + d0 * 32 + r32] = (unsigned char)(w_ & 0xff); }
      else Ow[(long)orow * LDO + d0 * 32 + r32] = (bf16_t)(cvtpk(v, v) & 0xffffu); } }
#undef TILE_TOK
#undef SLOAD
#undef SWRITE
#undef SWAIT
#undef RESC
#undef HOOK
#undef QKT
#undef PSM
#undef PVS
#undef PVONLY
#undef TV
#undef FSM
}
#undef KSWZ
#undef K8SWZ
#undef SBAR
}
constexpr int NWAVES = 8;
constexpr int BATCH = 2, SEQ = 8192, DM = 2048, DEPTH = 4, GRIDW = 64, HD = 128;
constexpr int M = BATCH * SEQ;
constexpr int INC = 13824, FF = 5632, NGU = 2 * FF;
constexpr int C_NAQ = 0, C_NAK = 1024, C_NAV = 2048, C_GQ = 3072, C_GK = 4096, C_GV = 4352, C_CH = 4608, C_CB = 5632, C_CC = 6656, C_GNA = 7680, C_GGQ = 9728, C_GCV = 11776;
constexpr float RMS_EPS = 1e-6f;
constexpr size_t MiB = 1u << 20;
constexpr size_t WS_CTL = 0, CTL_ZERO_BYTES = 1 * MiB;
constexpr size_t WS_ROPE = 1 * MiB;
constexpr size_t WS_WIN = 2 * MiB,    SZ_WIN = 54 * MiB;
constexpr size_t WS_WBR = 218 * MiB,  SZ_WBR = 4 * MiB;
constexpr size_t WS_WOUT = 266 * MiB, SZ_WOUT = 8 * MiB;
constexpr size_t WS_WGU = 298 * MiB,  SZ_WGU = 44 * MiB;
constexpr size_t WS_WDN = 474 * MiB,  SZ_WDN = 22 * MiB;
constexpr size_t WS_H = 562 * MiB;
constexpr size_t WS_SSX = WS_ROPE + 65536;
constexpr size_t WS_PROJ = 626 * MiB;
constexpr size_t WS_ACT = WS_PROJ;
constexpr size_t WS_ANA = 1058 * MiB, WS_AGQ = 1090 * MiB, WS_ACV = 1122 * MiB;
constexpr size_t WS_MRG = 1154 * MiB;
constexpr size_t WS_T = 1218 * MiB;
constexpr size_t WS_G8 = 1282 * MiB;
constexpr int NQKV = C_CH, NI8 = NQKV + (INC - C_GNA);
constexpr size_t WS_WG8 = 1378 * MiB, SZ_WG8 = (size_t)NI8 * 2048;
constexpr size_t WS_XB8 = WS_WG8 + 4 * SZ_WG8;
constexpr size_t WS_ASC = WS_ROPE + 131072;
constexpr size_t WS_WSC = WS_ROPE + 262144;
constexpr size_t WS_WGU8 = WS_XB8 + 32 * MiB, SZ_WGU8 = 22 * MiB;
constexpr size_t WS_WSCF = WS_ROPE + 524288;
constexpr size_t WS_WBR8 = WS_WGU8 + 4 * SZ_WGU8, SZ_WBR8 = 8 * MiB;
constexpr size_t WS_WSB = WS_ROPE + 786432;
constexpr size_t WS_END = WS_WBR8 + 4 * SZ_WBR8;
static_assert(WS_WSC + (size_t)4 * NI8 * 4 <= WS_WSCF && WS_WSCF + (size_t)4 * 11264 * 4 <= WS_WIN && SZ_WG8 % MiB == 0, "scale tables inside the rope MiB");
static_assert(SZ_WIN == (size_t)INC * DM * 2 && SZ_WGU == (size_t)NGU * DM * 2 && SZ_WDN == (size_t)DM * FF * 2 && WS_WIN + 4 * SZ_WIN == WS_WBR && WS_WBR + 12 * SZ_WBR == WS_WOUT && WS_WOUT + 4 * SZ_WOUT == WS_WGU &&
              WS_WGU + 4 * SZ_WGU == WS_WDN && WS_WDN + 4 * SZ_WDN == WS_H && WS_H + (size_t)M * DM * 2 == WS_PROJ && WS_PROJ + (size_t)M * INC * 2 == WS_ANA && WS_T + (size_t)M * DM * 2 == WS_G8 && WS_G8 + (size_t)3 * M * DM == WS_WG8 && WS_WG8 + 4 * SZ_WG8 == WS_XB8 && WS_XB8 + (size_t)M * DM == WS_WGU8 && WS_WGU8 + 4 * SZ_WGU8 == WS_WBR8 && SZ_WGU8 == (size_t)NGU * DM, "d_ws map");
constexpr int CW_TMO = 0;
constexpr int CW_BAR = 4096;
constexpr int CW_AMAX = 65536;
constexpr int CW_AMAXF = 65536 + 4 * NI8;
constexpr int CW_CNT = 16384;
static_assert((CW_CNT + 8 * 64 * 64) <= CW_AMAX && CW_AMAX + 4 * NI8 <= CW_AMAXF && (CW_AMAXF + 4 * 11264) * 4 <= (int)CTL_ZERO_BYTES, "CTL words inside the memset region");
constexpr int RING_OFF = 0, RING_BYTES = 131072;
constexpr int LDSCTL_OFF = RING_BYTES, MISC_OFF = LDSCTL_OFF + 320;
constexpr int RSTD_OFF = LDSCTL_OFF + 1024;
constexpr int XT_OFF = RSTD_OFF + 8192;
constexpr int LDS_BYTES = 151552;
static_assert(XT_OFF + 8192 <= LDS_BYTES, "LDS map");
static_assert(att::SHM_ATTN <= RING_BYTES, "attention LDS fits the ring region");

#define GAS __attribute__((address_space(1)))
#define LAS __attribute__((address_space(3)))
typedef unsigned short bf16;
typedef unsigned v4u __attribute__((ext_vector_type(4)));
typedef unsigned v2u __attribute__((ext_vector_type(2)));
typedef float f32x4 __attribute__((ext_vector_type(4)));
typedef GAS unsigned gu32;
#define RLX_AGENT __ATOMIC_RELAXED, __HIP_MEMORY_SCOPE_AGENT
#define LDS_WAIT() asm volatile("s_waitcnt lgkmcnt(0)" ::: "memory")
#define VM_WAIT() asm volatile("s_waitcnt vmcnt(0)" ::: "memory")
__device__ __forceinline__ unsigned f2bf(float f) { unsigned u = __builtin_bit_cast(unsigned, f); return (u + 0x7fffu + ((u >> 16) & 1u)) >> 16; }
__device__ __forceinline__ unsigned pk2(float lo, float hi) { return f2bf(lo) | (f2bf(hi) << 16); }
__device__ __forceinline__ float bflo(unsigned w) { return __uint_as_float(w << 16); }
__device__ __forceinline__ float bfhi(unsigned w) { return __uint_as_float(w & 0xffff0000u); }
#define XB_TMO      128
#define XB_XCNT(j)  (256  + 64 * (j))
#define XB_XSUB(j)  (1280 + 64 * (j))
#define XB_XGEN(j)  (2304 + 64 * (j))
#define XB_TOP      3328
#define XB_TOPGEN   3392
#define XCD_BAR_WORDS 3456
#define XB_SPIN_CAP (1u << 18)

__device__ __forceinline__ unsigned xb_ld(unsigned* p)              { return __hip_atomic_load(p, __ATOMIC_RELAXED, __HIP_MEMORY_SCOPE_AGENT); }
__device__ __forceinline__ unsigned xb_add(unsigned* p, unsigned v) { return __hip_atomic_fetch_add(p, v, __ATOMIC_RELAXED, __HIP_MEMORY_SCOPE_AGENT); }
__device__ __forceinline__ unsigned xb_xcc_id() { return (unsigned)__builtin_amdgcn_s_getreg((3 << 11) | 20) & 0xFu; }
#define XB_SPIN(cond, bar) do { unsigned _sp = 0; while (cond) { __builtin_amdgcn_s_sleep(1); \
    if ((++_sp & 255u) == 0u) { if (xb_ld(&(bar)[XB_TMO])) break; if (_sp > XB_SPIN_CAP) { atomicAdd(&(bar)[XB_TMO], 1u); break; } } } } while (0)

struct XcdBarrier {
    unsigned* bar; unsigned x;
    volatile LAS unsigned* st;
};

__device__ __forceinline__ XcdBarrier xcd_barrier_post(unsigned* bar, volatile LAS unsigned* st, const bool t0  ) {
    XcdBarrier b; b.bar = bar; b.x = xb_xcc_id(); b.st = st;
    if (t0) (void)xb_add(&bar[XB_XCNT(b.x)], 1u);
    return b;
}
__device__ __forceinline__ void xcd_barrier_complete(unsigned* bar, unsigned x, unsigned& nloc, unsigned& nx) {
    const unsigned G = gridDim.x * gridDim.y * gridDim.z;
    unsigned sum, cnt, mine, sp = 0u;
    for (;;) {
        sum = 0u; cnt = 0u; mine = 0u;
#pragma unroll
        for (unsigned j = 0; j < 16; ++j) { const unsigned c = xb_ld(&bar[XB_XCNT(j)]); sum += c; cnt += (c > 0u) ? 1u : 0u; mine = (j == x) ? c : mine; }
        if (sum == G) break;
        __builtin_amdgcn_s_sleep(1);
        if ((++sp & 255u) == 0u) { if (xb_ld(&bar[XB_TMO])) break; if (sp > XB_SPIN_CAP) { atomicAdd(&bar[XB_TMO], 1u); break; } }
    }
    nloc = mine > 0u ? mine : 1u; nx = cnt > 0u ? cnt : 1u;
}

__device__ __forceinline__ void xcd_barrier(const XcdBarrier& b, const bool t0) {
    asm volatile("s_waitcnt vmcnt(0)" ::: "memory");
    __syncthreads();
    if (t0) {
        unsigned* bar = b.bar;
        __builtin_amdgcn_s_waitcnt(0);
        unsigned nloc = b.st[0], nx = b.st[1];
        if (nloc == 0u) { xcd_barrier_complete(bar, b.x, nloc, nx); b.st[0] = nloc; b.st[1] = nx; }
        const unsigned old = xb_add(&bar[XB_XSUB(b.x)], 1u);
        const unsigned gen = old / nloc;
        if (old + 1u == (gen + 1u) * nloc) {
            __builtin_amdgcn_fence(__ATOMIC_RELEASE, "agent");
            asm volatile("s_waitcnt vmcnt(0)" ::: "memory");
            const unsigned og = xb_add(&bar[XB_TOP], 1u);
            const unsigned tg = og / nx;
            if (og + 1u == (tg + 1u) * nx) xb_add(&bar[XB_TOPGEN], 1u);
            else XB_SPIN(xb_ld(&bar[XB_TOPGEN]) == tg, bar);
            __builtin_amdgcn_fence(__ATOMIC_ACQUIRE, "agent");
            xb_add(&bar[XB_XGEN(b.x)], 1u);
            asm volatile("s_waitcnt vmcnt(0)" ::: "memory");
        } else {
            XB_SPIN(xb_ld(&bar[XB_XGEN(b.x)]) == gen, bar);
            __builtin_amdgcn_fence(__ATOMIC_ACQUIRE, "agent");
            asm volatile("s_waitcnt vmcnt(0)" ::: "memory");
        }
    }
    __syncthreads();
}
#ifndef NT_LOADS
#define NT_LOADS 1
#endif
#if NT_LOADS
#define NTLD(p) __builtin_nontemporal_load(p)
#else
#define NTLD(p) (*(p))
#endif
struct Frame {
    LAS unsigned char* lds;
    volatile LAS unsigned* MISC;
    gu32* ctl;
    int wave;
    int vcu, G;
    unsigned char* ws;
};
#define FTID (F.wave * 64 + lane_id())
#define FLANE (lane_id())
__device__ __forceinline__ float wave_sum(float v, int lane) {
#pragma unroll
    for (int o = 1; o < 64; o <<= 1) v += shfl_xor_l(v, o, lane);
    return v;
}

#ifndef Q8_CLIP
#define Q8_CLIP 0.0f
#endif
__device__ __forceinline__ unsigned q8(float v) { return (unsigned)(int)__builtin_rintf(fminf(fmaxf(v, -127.0f), 127.0f)) & 0xffu; }
__device__ __forceinline__ void transpose_item(const float* __restrict__ W, int ldk, int N, bf16* __restrict__ WT, LAS float* scr, int k0, int kd0, int n0, int drow, int rstride, int lane, const float* __restrict__ gk, unsigned* __restrict__ camax = nullptr  ) {
#ifndef TR_UNROLL
#define TR_UNROLL 16
#endif
#pragma unroll TR_UNROLL
    for (int i = 0; i < 32; ++i) { const int kk = 2 * i + (lane >> 5); scr[kk * 33 + (lane & 31)] = NTLD(&W[(size_t)(k0 + kk) * N + n0 + (lane & 31)]); }
    LDS_WAIT(); asm volatile("" ::: "memory");
    const int c = lane & 7;
    f32x4 ga = (f32x4){1.f, 1.f, 1.f, 1.f}, gb = ga; if (gk) { ga = *(const f32x4*)(gk + k0 + 8 * c); gb = *(const f32x4*)(gk + k0 + 8 * c + 4); }
#pragma unroll
    for (int j = 0; j < 4; ++j) { const int n = (lane >> 3) + 8 * j; const LAS float* s = scr + (8 * c) * 33 + n;
        v4u o; o.x = pk2(s[0 * 33] * ga.x, s[1 * 33] * ga.y); o.y = pk2(s[2 * 33] * ga.z, s[3 * 33] * ga.w); o.z = pk2(s[4 * 33] * gb.x, s[5 * 33] * gb.y); o.w = pk2(s[6 * 33] * gb.z, s[7 * 33] * gb.w);
        *(GAS v4u*)(WT + (size_t)(drow + n * rstride) * ldk + kd0 + 8 * c) = o;
        if (camax) { float m = fmaxf(fmaxf(fmaxf(fabsf(s[0 * 33] * ga.x), fabsf(s[1 * 33] * ga.y)), fmaxf(fabsf(s[2 * 33] * ga.z), fabsf(s[3 * 33] * ga.w))), fmaxf(fmaxf(fabsf(s[4 * 33] * gb.x), fabsf(s[5 * 33] * gb.y)), fmaxf(fabsf(s[6 * 33] * gb.z), fabsf(s[7 * 33] * gb.w))));
            m = fmaxf(m, shfl_xor_l(m, 1, lane)); m = fmaxf(m, shfl_xor_l(m, 2, lane)); m = fmaxf(m, shfl_xor_l(m, 4, lane));
            if (c == 0) atomicMax(camax + n * rstride, __float_as_uint(m)); } }
    LDS_WAIT(); asm volatile("" ::: "memory");
}
__device__ __forceinline__ void gate_item(const float* __restrict__ W, int N, LAS float* scr, int k0, int n0, int gcol0, int lane, const float* __restrict__ gk, unsigned* __restrict__ camax, unsigned char* __restrict__ W8, float* __restrict__ wsc, const int pass) {
#pragma unroll 8
    for (int i = 0; i < 32; ++i) { const int kk = 2 * i + (lane >> 5); scr[kk * 33 + (lane & 31)] = W[(size_t)(k0 + kk) * N + n0 + (lane & 31)]; }
    LDS_WAIT(); asm volatile("" ::: "memory");
    const int c = lane & 7;
    const f32x4 ga = *(const f32x4*)(gk + k0 + 8 * c), gb = *(const f32x4*)(gk + k0 + 8 * c + 4);
#pragma unroll
    for (int j = 0; j < 4; ++j) { const int n = (lane >> 3) + 8 * j; const LAS float* s = scr + (8 * c) * 33 + n;
        const float v0 = s[0 * 33] * ga.x, v1 = s[1 * 33] * ga.y, v2 = s[2 * 33] * ga.z, v3 = s[3 * 33] * ga.w, v4 = s[4 * 33] * gb.x, v5 = s[5 * 33] * gb.y, v6 = s[6 * 33] * gb.z, v7 = s[7 * 33] * gb.w;
        if (pass == 1) { float m = fmaxf(fmaxf(fmaxf(fabsf(v0), fabsf(v1)), fmaxf(fabsf(v2), fabsf(v3))), fmaxf(fmaxf(fabsf(v4), fabsf(v5)), fmaxf(fabsf(v6), fabsf(v7))));
            m = fmaxf(m, shfl_xor_l(m, 1, lane)); m = fmaxf(m, shfl_xor_l(m, 2, lane)); m = fmaxf(m, shfl_xor_l(m, 4, lane));
            if (c == 0) atomicMax(camax + gcol0 + n, __float_as_uint(m)); }
        else { const float am = fmaxf(__uint_as_float(__hip_atomic_load(camax + gcol0 + n, RLX_AGENT)), 1e-30f), inv = 127.0f / am;
            v2u o; o.x = q8(v0 * inv) | (q8(v1 * inv) << 8) | (q8(v2 * inv) << 16) | (q8(v3 * inv) << 24); o.y = q8(v4 * inv) | (q8(v5 * inv) << 8) | (q8(v6 * inv) << 16) | (q8(v7 * inv) << 24);
            *(GAS v2u*)(W8 + (size_t)(gcol0 + n) * DM + k0 + 8 * c) = o;
            if (k0 == 0 && c == 0) wsc[gcol0 + n] = am * (1.0f / 127.0f); } }
    LDS_WAIT(); asm volatile("" ::: "memory");
}
__device__ __forceinline__ void i8_item(const float* __restrict__ W, const int N, const int n0, const float* __restrict__ gk, unsigned char* __restrict__ W8, float* __restrict__ wsc, const int drow, const int rstride, LAS unsigned char* lds, const int wave, const int lane) {
    LAS unsigned* st = (LAS unsigned*)lds; LAS float* amx = (LAS float*)(lds + 32 * 513 * 4);
    const int n = lane & 31, h = lane >> 5, kb = h * 1024 + wave * 128;
    const GAS float* wp = (const GAS float*)W + (size_t)kb * N + n0 + n;
    const float* gq0 = gk + wave * 128; const float* gq1 = gk + 1024 + wave * 128;
    unsigned pk[64]; float am = 0.f;
    float wa[32], wb[32];
#define I8_LOAD(dst, bt) do { _Pragma("unroll") for (int i_ = 0; i_ < 32; ++i_) dst[i_] = NTLD(&wp[(size_t)(32 * (bt) + i_) * N]); } while (0)
#define I8_USE(src, bt) do { _Pragma("unroll") for (int i_ = 0; i_ < 16; ++i_) { const int k_ = 32 * (bt) + 2 * i_; \
        const float v0_ = src[2 * i_] * (h ? gq1[k_] : gq0[k_]), v1_ = src[2 * i_ + 1] * (h ? gq1[k_ + 1] : gq0[k_ + 1]); const unsigned b_ = pk2(v0_, v1_); pk[16 * (bt) + i_] = b_; \
        am = fmaxf(am, fmaxf(fabsf(bflo(b_)), fabsf(bfhi(b_)))); } } while (0)
    I8_LOAD(wa, 0); __builtin_amdgcn_sched_barrier(0);
    I8_LOAD(wb, 1); __builtin_amdgcn_sched_barrier(0);
    I8_USE(wa, 0); __builtin_amdgcn_sched_barrier(0);
    I8_LOAD(wa, 2); __builtin_amdgcn_sched_barrier(0);
    I8_USE(wb, 1); __builtin_amdgcn_sched_barrier(0);
    I8_LOAD(wb, 3); __builtin_amdgcn_sched_barrier(0);
    I8_USE(wa, 2); __builtin_amdgcn_sched_barrier(0);
    I8_USE(wb, 3); __builtin_amdgcn_sched_barrier(0);
#undef I8_LOAD
#undef I8_USE
    amx[(wave * 2 + h) * 32 + n] = am;
    __syncthreads();
    float cm = amx[n];
#pragma unroll
    for (int q = 1; q < 16; ++q) cm = fmaxf(cm, amx[q * 32 + n]);
    cm = fmaxf(cm, 1e-30f); const float inv = 127.0f / cm;
#pragma unroll
    for (int j = 0; j < 32; ++j) { const unsigned a_ = pk[2 * j], b_ = pk[2 * j + 1];
        st[n * 513 + (kb >> 2) + j] = q8(bflo(a_) * inv) | (q8(bfhi(a_) * inv) << 8) | (q8(bflo(b_) * inv) << 16) | (q8(bfhi(b_) * inv) << 24); }
    __syncthreads();
    const int tid = wave * 64 + lane;
#pragma unroll 4
    for (int idx = tid; idx < 32 * 512; idx += NWAVES * 64) { const int r = idx >> 9, d = idx & 511; ((GAS unsigned*)(W8 + (size_t)(drow + r * rstride) * DM))[d] = st[r * 513 + d]; }
    if (tid < 32) wsc[drow + tid * rstride] = cm * (1.0f / 127.0f);
    __syncthreads();
}
__device__ __forceinline__ float wave_max(float v, int lane) {
#pragma unroll
    for (int o = 1; o < 64; o <<= 1) v = fmaxf(v, shfl_xor_l(v, o, lane));
    return v;
}
__device__ __forceinline__ void xb_row(const float* __restrict__ xrow, bf16* __restrict__ hrow, float* __restrict__ ssx, unsigned char* __restrict__ x8row, float* __restrict__ asc, int lane) {
    const GAS f32x4* xr = (const GAS f32x4*)xrow + lane; GAS v2u* o8 = (GAS v2u*)hrow + lane; float s = 0.f, am = 0.f; f32x4 v[8];
#pragma unroll
    for (int j = 0; j < 8; ++j) { v[j] = xr[64 * j]; s += (v[j].x * v[j].x + v[j].y * v[j].y) + (v[j].z * v[j].z + v[j].w * v[j].w); am = fmaxf(fmaxf(am, fmaxf(fabsf(v[j].x), fabsf(v[j].y))), fmaxf(fabsf(v[j].z), fabsf(v[j].w)));
        v2u w; w.x = pk2(v[j].x, v[j].y); w.y = pk2(v[j].z, v[j].w); o8[64 * j] = w; }
    s = wave_sum(s, lane); am = fmaxf(wave_max(am, lane), 1e-30f); if (Q8_CLIP > 0.f) am = fminf(am, Q8_CLIP * __builtin_sqrtf(s * (1.0f / DM)));
    const float inv = 127.0f / am;
#pragma unroll
    for (int j = 0; j < 8; ++j) ((GAS unsigned*)x8row + lane)[64 * j] = q8(v[j].x * inv) | (q8(v[j].y * inv) << 8) | (q8(v[j].z * inv) << 16) | (q8(v[j].w * inv) << 24);
    if (lane == 0) { *ssx = s; *asc = am * (1.0f / 127.0f); }
}
template <bool XF32, bool FOUT, bool Q8, int R>
__device__ __forceinline__ void post_rows_bf(const bf16* __restrict__ T, const float* __restrict__ xf, const bf16* XBp, const float* __restrict__ gpost, float* __restrict__ ssx, float* __restrict__ fout, unsigned char* __restrict__ X8, float* __restrict__ asc, const int (&rows)[R], int lane, bf16* XBo) {
    v4u tw[R][4]; v4u xw[R][4]; f32x4 xa[R][4], xb2[R][4];
#pragma unroll
    for (int r = 0; r < R; ++r)
#pragma unroll
        for (int j = 0; j < 4; ++j) { const size_t e = (size_t)rows[r] * DM + 8 * (64 * j + lane);
            tw[r][j] = NTLD((const GAS v4u*)(T + e));
            if constexpr (XF32) { xa[r][j] = NTLD((const GAS f32x4*)(xf + e)); xb2[r][j] = NTLD((const GAS f32x4*)(xf + e + 4)); } else xw[r][j] = NTLD((const GAS v4u*)(XBp + e)); }
    f32x4 g0[4], g1[4];
#pragma unroll
    for (int j = 0; j < 4; ++j) { g0[j] = *(const GAS f32x4*)(gpost + 8 * (64 * j + lane)); g1[j] = *(const GAS f32x4*)(gpost + 8 * (64 * j + lane) + 4); }
    float s[R];
#pragma unroll
    for (int r = 0; r < R; ++r) { float a = 0.f;
#pragma unroll
        for (int j = 0; j < 4; ++j) { const v4u w = tw[r][j]; const float t0 = bflo(w.x), t1 = bfhi(w.x), t2 = bflo(w.y), t3 = bfhi(w.y), t4 = bflo(w.z), t5 = bfhi(w.z), t6 = bflo(w.w), t7 = bfhi(w.w);
            a += ((t0 * t0 + t1 * t1) + (t2 * t2 + t3 * t3)) + ((t4 * t4 + t5 * t5) + (t6 * t6 + t7 * t7)); }
        s[r] = a; }
#pragma unroll
    for (int o = 1; o < 64; o <<= 1)
#pragma unroll
        for (int r = 0; r < R; ++r) s[r] += shfl_xor_l(s[r], o, lane);
#pragma unroll
    for (int r = 0; r < R; ++r) { const float rstd = __builtin_amdgcn_rsqf(s[r] * (1.f / DM) + RMS_EPS); float s2 = 0.f, am = 0.f;
#pragma unroll
        for (int j = 0; j < 4; ++j) { const v4u w = tw[r][j]; f32x4 xl, xh;
            if constexpr (XF32) { xl = xa[r][j]; xh = xb2[r][j]; } else { const v4u q = xw[r][j]; xl = (f32x4){bflo(q.x), bfhi(q.x), bflo(q.y), bfhi(q.y)}; xh = (f32x4){bflo(q.z), bfhi(q.z), bflo(q.w), bfhi(q.w)}; }
            xl = xl + (f32x4){bflo(w.x), bfhi(w.x), bflo(w.y), bfhi(w.y)} * rstd * g0[j]; xh = xh + (f32x4){bflo(w.z), bfhi(w.z), bflo(w.w), bfhi(w.w)} * rstd * g1[j];
            const size_t e = (size_t)rows[r] * DM + 8 * (64 * j + lane);
            if constexpr (FOUT) { *(GAS f32x4*)(fout + e) = xl; *(GAS f32x4*)(fout + e + 4) = xh; }
            else { v4u o; o.x = pk2(xl.x, xl.y); o.y = pk2(xl.z, xl.w); o.z = pk2(xh.x, xh.y); o.w = pk2(xh.z, xh.w); *(GAS v4u*)(XBo + e) = o; }
            s2 += ((xl.x * xl.x + xl.y * xl.y) + (xl.z * xl.z + xl.w * xl.w)) + ((xh.x * xh.x + xh.y * xh.y) + (xh.z * xh.z + xh.w * xh.w));
            if constexpr (Q8) am = fmaxf(fmaxf(fmaxf(am, fmaxf(fabsf(xl.x), fabsf(xl.y))), fmaxf(fabsf(xl.z), fabsf(xl.w))), fmaxf(fmaxf(fabsf(xh.x), fabsf(xh.y)), fmaxf(fabsf(xh.z), fabsf(xh.w)))); }
        if constexpr (!FOUT) { s2 = wave_sum(s2, lane); if (lane == 0) ssx[rows[r]] = s2; }
        if constexpr (Q8) {
            am = fmaxf(wave_max(am, lane), 1e-30f); if (Q8_CLIP > 0.f) am = fminf(am, Q8_CLIP * __builtin_sqrtf(s2 * (1.0f / DM)));
            const float inv = 127.0f / am; if (lane == 0) asc[rows[r]] = am * (1.0f / 127.0f);
#pragma unroll
            for (int j = 0; j < 4; ++j) { const v4u w = tw[r][j]; f32x4 xl, xh;
                if constexpr (XF32) { xl = xa[r][j]; xh = xb2[r][j]; } else { const v4u q = xw[r][j]; xl = (f32x4){bflo(q.x), bfhi(q.x), bflo(q.y), bfhi(q.y)}; xh = (f32x4){bflo(q.z), bfhi(q.z), bflo(q.w), bfhi(q.w)}; }
                xl = xl + (f32x4){bflo(w.x), bfhi(w.x), bflo(w.y), bfhi(w.y)} * rstd * g0[j]; xh = xh + (f32x4){bflo(w.z), bfhi(w.z), bflo(w.w), bfhi(w.w)} * rstd * g1[j];
                v2u o; o.x = q8(xl.x * inv) | (q8(xl.y * inv) << 8) | (q8(xl.z * inv) << 16) | (q8(xl.w * inv) << 24); o.y = q8(xh.x * inv) | (q8(xh.y * inv) << 8) | (q8(xh.z * inv) << 16) | (q8(xh.w * inv) << 24);
                *(GAS v2u*)(X8 + (size_t)rows[r] * DM + 8 * (64 * j + lane)) = o; } } }
}
__device__ __forceinline__ void conv_rows(Frame& F, const bf16* __restrict__ proj, const float* __restrict__ cw, const float* __restrict__ cb, bf16* __restrict__ acv, const int apitch  ) {
    int ln = FLANE; asm volatile("" : "+v"(ln));
    const int gw = F.vcu * NWAVES + F.wave, NGW = F.G * NWAVES; const int c0 = ln * 16;
    float w0[16], w1[16], w2[16], bb[16];
#pragma unroll
    for (int e = 0; e < 16; ++e) { w0[e] = cw[c0 + e]; w1[e] = cw[1024 + c0 + e]; w2[e] = cw[2048 + c0 + e]; bb[e] = cb[c0 + e]; }
#define CONV_U(dst, mrow) do { const v4u* ph_ = (const v4u*)(proj + (size_t)(mrow) * INC + C_CH + c0); const v4u* pc_ = (const v4u*)(proj + (size_t)(mrow) * INC + C_CC + c0); \
        const v4u h0_ = ph_[0], h1_ = ph_[1], g0_ = pc_[0], g1_ = pc_[1]; \
        dst[0] = bflo(h0_.x) * bflo(g0_.x); dst[1] = bfhi(h0_.x) * bfhi(g0_.x); dst[2] = bflo(h0_.y) * bflo(g0_.y); dst[3] = bfhi(h0_.y) * bfhi(g0_.y); \
        dst[4] = bflo(h0_.z) * bflo(g0_.z); dst[5] = bfhi(h0_.z) * bfhi(g0_.z); dst[6] = bflo(h0_.w) * bflo(g0_.w); dst[7] = bfhi(h0_.w) * bfhi(g0_.w); \
        dst[8] = bflo(h1_.x) * bflo(g1_.x); dst[9] = bfhi(h1_.x) * bfhi(g1_.x); dst[10] = bflo(h1_.y) * bflo(g1_.y); dst[11] = bfhi(h1_.y) * bfhi(g1_.y); \
        dst[12] = bflo(h1_.z) * bflo(g1_.z); dst[13] = bfhi(h1_.z) * bfhi(g1_.z); dst[14] = bflo(h1_.w) * bflo(g1_.w); dst[15] = bfhi(h1_.w) * bfhi(g1_.w); } while (0)
    for (int m0 = gw * 8; m0 < M; m0 += NGW * 8) {
        float up[16], uc[16], un[16];
        if ((m0 & (SEQ - 1)) == 0) {
#pragma unroll
            for (int e = 0; e < 16; ++e) up[e] = 0.f;
        } else CONV_U(up, m0 - 1);
        CONV_U(uc, m0);
        for (int r = 0; r < 8; ++r) { const int m = m0 + r;
            if ((m & (SEQ - 1)) == SEQ - 1) {
#pragma unroll
                for (int e = 0; e < 16; ++e) un[e] = 0.f;
            } else CONV_U(un, m + 1);
            const v4u* pb = (const v4u*)(proj + (size_t)m * INC + C_CB + c0); const v4u b0 = pb[0], b1 = pb[1];
            const float bg[16] = {bflo(b0.x), bfhi(b0.x), bflo(b0.y), bfhi(b0.y), bflo(b0.z), bfhi(b0.z), bflo(b0.w), bfhi(b0.w), bflo(b1.x), bfhi(b1.x), bflo(b1.y), bfhi(b1.y), bflo(b1.z), bfhi(b1.z), bflo(b1.w), bfhi(b1.w)};
            float y[16];
#pragma unroll
            for (int e = 0; e < 16; ++e) y[e] = bg[e] * (bb[e] + w0[e] * up[e] + w1[e] * uc[e] + w2[e] * un[e]);
            v4u o0, o1; o0.x = pk2(y[0], y[1]); o0.y = pk2(y[2], y[3]); o0.z = pk2(y[4], y[5]); o0.w = pk2(y[6], y[7]); o1.x = pk2(y[8], y[9]); o1.y = pk2(y[10], y[11]); o1.z = pk2(y[12], y[13]); o1.w = pk2(y[14], y[15]);
            v4u* po = (v4u*)(acv + (size_t)m * apitch + c0); po[0] = o0; po[1] = o1;
#pragma unroll
            for (int e = 0; e < 16; ++e) { up[e] = uc[e]; uc[e] = un[e]; }
        }
    }
#undef CONV_U
}

#ifndef REP_P0
#define REP_P0 1
#endif
#ifndef REP_P1
#define REP_P1 1
#endif
#ifndef REP_P3
#define REP_P3 1
#endif
#ifndef REP_P4
#define REP_P4 1
#endif
#ifndef REP_P5
#define REP_P5 1
#endif
#ifndef REP_P7
#define REP_P7 1
#endif
#ifndef REP_P8
#define REP_P8 1
#endif
#ifndef GQA_K8
#define GQA_K8 1
#endif
#ifndef GQA_V8
#define GQA_V8 1
#endif
#ifndef BR8
#define BR8 1
#endif
#ifndef BR8_MIX
#define BR8_MIX 16
#endif
#ifndef NA_K8
#define NA_K8 0
#endif
#ifndef GQA_SDEPTH_FIXED
#define GQA_SDEPTH_FIXED 1
#endif
#ifndef GQA_SDEPTH
#define GQA_SDEPTH 1
#endif
struct Args { const float* in[18]; float* out; unsigned char* ws; };
typedef const __attribute__((address_space(4))) Args* KArgP;
__device__ __forceinline__ KArgP kargs() { KArgP p = (KArgP)__builtin_amdgcn_kernarg_segment_ptr(); asm volatile("" : "+s"(p)); return p; }
#define AIN(k) (kargs()->in[k])
__global__ void __launch_bounds__(NWAVES * 64, 2) mega_fwd(Args args) {
    extern __shared__ __attribute__((aligned(16))) unsigned char lds[];
    Frame F;
    F.lds = (LAS unsigned char*)lds;
    F.MISC = (volatile LAS unsigned*)(F.lds + MISC_OFF);
    F.wave = __builtin_amdgcn_readfirstlane((int)threadIdx.x >> 6);

    F.G = gridDim.x; { const int bx = blockIdx.x; F.vcu = (F.G % 8 == 0) ? (bx % 8) * (F.G / 8) + bx / 8 : bx; }
    F.ws = args.ws; F.ctl = (gu32*)(args.ws + WS_CTL);
#define ws (kargs()->ws)
#define x_in AIN(0)
#define out (kargs()->out)
#define Hb ((bf16*)(ws + WS_H))
#define PROJ ((bf16*)(ws + WS_PROJ))
#define ACT ((bf16*)(ws + WS_ACT))
#define ABR ((bf16*)(ws + WS_ANA))
#define MRG ((bf16*)(ws + WS_MRG))
#define SSX ((float*)(ws + WS_SSX))
#define XB8 ((unsigned char*)(ws + WS_XB8))
#define ASC ((float*)(ws + WS_ASC))
#define WSC ((float*)(ws + WS_WSC))
#define WSCF ((float*)(ws + WS_WSCF))
#define Tb ((bf16*)(ws + WS_T))
#define KC ((bf16*)(ws + WS_T))
#define VC ((bf16*)(ws + WS_T + 8 * MiB))
#define KC8 ((unsigned char*)(ws + WS_T + 16 * MiB))
#define KN8 ((unsigned char*)(ws + WS_T + 20 * MiB))
#define VT8 ((unsigned char*)(ws + WS_T + 36 * MiB))
#define rope ((float*)(ws + WS_ROPE))
    for (int u = FTID; u < (LDS_BYTES - LDSCTL_OFF) / 4; u += NWAVES * 64) ((LAS unsigned*)(F.lds + LDSCTL_OFF))[u] = 0u;
    __syncthreads();
    XcdBarrier bar = xcd_barrier_post((unsigned*)(F.ctl + CW_BAR), F.MISC + 8, FTID == 0);
#ifndef REP_BAR
#define REP_BAR 1
#endif
#define GRID_BAR() do { for (int rb_ = 0; rb_ < REP_BAR; ++rb_) xcd_barrier(bar, FTID == 0); } while (0)
    const int gw = F.vcu * NWAVES + F.wave, NGW = F.G * NWAVES;
#ifdef PROBE_TS
#define TS_B(id) do { if ((id) == PROBE_TS && l == PROBE_TS_L && blockIdx.x == 0 && FTID == 0) F.MISC[16] = (unsigned)__builtin_amdgcn_s_memrealtime(); } while (0)
#define TS_E(id) do { if ((id) == PROBE_TS && l == PROBE_TS_L && blockIdx.x == 0 && FTID == 0) F.MISC[17] = (unsigned)__builtin_amdgcn_s_memrealtime() - F.MISC[16]; } while (0)
#else
#define TS_B(id) do {} while (0)
#define TS_E(id) do {} while (0)
#endif

    for (int rep_ = 0; rep_ < REP_P0; ++rep_) {
    {
        LAS float* scr = (LAS float*)(F.lds + RING_OFF + F.wave * 16384);
        constexpr int NCONV = C_GNA - C_CH;
        constexpr int I_IN = (DM / 64) * (NCONV / 32), I_BR = (1024 / 64) * (DM / 32), I_OUT = (DM / 64) * (DM / 32), I_D = (FF / 64) * (DM / 32);
        constexpr int I_LAYER = I_IN + 3 * I_BR + I_OUT + I_D;
#ifndef NO_TRANS
#ifndef REP_TR
#define REP_TR 1
#endif
        for (int rt_ = 0; rt_ < REP_TR; ++rt_)
        for (int it = gw; it < DEPTH * I_LAYER; it += NGW) {
            const int l = it / I_LAYER; int r = it - l * I_LAYER;
            const float* W; bf16* WT; const float* gk = nullptr; int K, N, koff = 0, nofs = 0;
            if (r < I_IN) { W = AIN(1) + (size_t)l * DM * INC; WT = (bf16*)(ws + WS_WIN + l * SZ_WIN); K = DM; N = INC; gk = AIN(11) + l * DM; nofs = C_CH; }
            else if ((r -= I_IN) < 3 * I_BR) { const int br = r / I_BR; r -= br * I_BR; W = AIN(7 + br) + (size_t)l * 1024 * DM; WT = (bf16*)(ws + WS_WBR + (size_t)l * 3 * SZ_WBR); K = 3072; N = DM; koff = br * 1024; }
            else if ((r -= 3 * I_BR) < I_OUT) { W = AIN(10) + (size_t)l * DM * DM; WT = (bf16*)(ws + WS_WOUT + l * SZ_WOUT); K = DM; N = DM; }
            else { r -= I_OUT; W = AIN(17) + (size_t)l * FF * DM; WT = (bf16*)(ws + WS_WDN + l * SZ_WDN); K = FF; N = DM; }
            const int nblk = (nofs ? NCONV : N) / 32, kb = r / nblk, nb = r - kb * nblk, n0 = nofs + 32 * nb;
            transpose_item(W, K, N, WT, scr, 64 * kb, koff + 64 * kb, n0, n0, 1, FLANE, gk, nullptr);
        }
#endif
        __syncthreads();
        {
            constexpr int J_IN = NI8 / 32, J_G = FF / 32, J_LAYER = J_IN + 2 * J_G;
            int ln_ = FLANE; asm volatile("" : "+v"(ln_));
#ifndef REP_I8
#define REP_I8 1
#endif
            for (int ri_ = 0; ri_ < REP_I8; ++ri_)
            for (int it = F.vcu; it < DEPTH * J_LAYER; it += F.G) {
                const int l = it / J_LAYER; int r = it - l * J_LAYER;
                if (r < J_IN) {
                    const int n0 = r < NQKV / 32 ? 32 * r : C_GNA + 32 * (r - NQKV / 32); int drow = n0, rstride = 1;
                    if (n0 >= C_GQ && n0 < C_GV) { const int B_ = (n0 & 127) >> 5; drow = (n0 & ~127) + 64 * (B_ >> 1) + (B_ & 1); rstride = 2; }
                    const int r8 = drow < C_CH ? drow : drow - C_GNA + NQKV;
                    i8_item(AIN(1) + (size_t)l * DM * INC, INC, n0, AIN(11) + l * DM, (unsigned char*)(ws + WS_WG8 + l * SZ_WG8), WSC + l * NI8, r8, rstride, F.lds + RING_OFF, F.wave, ln_);
                } else { r -= J_IN; const int up = r / J_G, n0 = 32 * (r - up * J_G), drow = (n0 >> 7) * 256 + up * 128 + (n0 & 127);
                    i8_item(AIN(15 + up) + (size_t)l * DM * FF, FF, n0, AIN(13) + l * DM, (unsigned char*)(ws + WS_WGU8 + l * SZ_WGU8), WSCF + l * NGU, drow, 1, F.lds + RING_OFF, F.wave, ln_); }
            }
        }
#if BR8
        GRID_BAR();
        {
            const int ln3 = FLANE;
            for (int row = gw; row < DEPTH * DM; row += NGW) {
                const int l3 = row >> 11, n3 = row & (DM - 1);
                const bf16* src = (const bf16*)(ws + WS_WBR + (size_t)l3 * 3 * SZ_WBR) + (size_t)n3 * 3072; unsigned char* dst = (unsigned char*)(ws + WS_WBR8 + (size_t)l3 * SZ_WBR8) + (size_t)n3 * 4096;
                v4u w[6]; float am = 0.f;
#pragma unroll
                for (int q = 0; q < 6; ++q) { w[q] = *(const GAS v4u*)(src + 8 * (64 * q + ln3));
                    am = fmaxf(am, fmaxf(fmaxf(fmaxf(fabsf(bflo(w[q].x)), fabsf(bfhi(w[q].x))), fmaxf(fabsf(bflo(w[q].y)), fabsf(bfhi(w[q].y)))), fmaxf(fmaxf(fabsf(bflo(w[q].z)), fabsf(bfhi(w[q].z))), fmaxf(fabsf(bflo(w[q].w)), fabsf(bfhi(w[q].w)))))); }
                am = fmaxf(wave_max(am, ln3), 1e-30f);
                const int ex = 134 - (int)((__float_as_uint(am) >> 23) & 0xffu);
                const float p = __uint_as_float((unsigned)(min(max(ex, -100), 100) + 127) << 23);
#pragma unroll
                for (int q = 0; q < 4; ++q) { int w0 = 0, w1 = 0;
                    w0 = __builtin_amdgcn_cvt_pk_fp8_f32(bflo(w[q].x) * p, bfhi(w[q].x) * p, w0, false); w0 = __builtin_amdgcn_cvt_pk_fp8_f32(bflo(w[q].y) * p, bfhi(w[q].y) * p, w0, true);
                    w1 = __builtin_amdgcn_cvt_pk_fp8_f32(bflo(w[q].z) * p, bfhi(w[q].z) * p, w1, false); w1 = __builtin_amdgcn_cvt_pk_fp8_f32(bflo(w[q].w) * p, bfhi(w[q].w) * p, w1, true);
                    v2u o; o.x = (unsigned)w0; o.y = (unsigned)w1; *(GAS v2u*)(dst + 8 * (64 * q + ln3)) = o; }
#pragma unroll
                for (int q = 4; q < 6; ++q) { v4u o; o.x = pk2(bflo(w[q].x) * p, bfhi(w[q].x) * p); o.y = pk2(bflo(w[q].y) * p, bfhi(w[q].y) * p); o.z = pk2(bflo(w[q].z) * p, bfhi(w[q].z) * p); o.w = pk2(bflo(w[q].w) * p, bfhi(w[q].w) * p);
                    *(GAS v4u*)(dst + 2048 + 16 * (64 * (q - 4) + ln3)) = o; }
                if (ln3 == 0) ((float*)(ws + WS_WSB))[row] = 1.0f / p;
            }
        }
#endif
#ifndef NO_ROPE
        for (int e = F.vcu * NWAVES * 64 + FTID; e < 192 * 32; e += F.G * NWAVES * 64) {
            const int pos = e >> 5, i = e & 31; const int p = pos < 128 ? pos : pos - 128;
            const float inv = 1.0f / powf(10000.0f, (float)i * (1.0f / 32.0f));
            const float ang = (float)p * inv;
            rope[2 * e] = cosf(ang); rope[2 * e + 1] = sinf(ang);
        }
#endif

        { int ln = FLANE; asm volatile("" : "+v"(ln)); for (int m = gw; m < M; m += NGW) xb_row(x_in + (size_t)m * DM, Hb + (size_t)m * DM, SSX + m, XB8 + (size_t)m * DM, ASC + m, ln); }
    }
    GRID_BAR();
    }

    for (int l = 0; l < DEPTH; ++l) {
        TS_B(1);
        for (int rep_ = 0; rep_ < REP_P1; ++rep_) {
        {
            pg8::Gemm g{Hb, (const bf16*)(ws + WS_WIN + l * SZ_WIN) + (size_t)C_CH * DM, M, C_GNA - C_CH, DM}; pg8::StaticOrder S; S.init(M, C_GNA - C_CH, F.G, (int)blockIdx.x);
            { LAS float* rt_ = (LAS float*)(F.lds + RSTD_OFF); const int rb_ = ((int)blockIdx.x & 7) * 2048;
              int t0_ = FTID; asm volatile("" : "+v"(t0_));
              for (int r_ = t0_; r_ < 2048; r_ += NWAVES * 64) rt_[r_] = __builtin_amdgcn_rsqf(SSX[rb_ + r_] * (1.0f / DM) + RMS_EPS);
              __syncthreads(); }
            pg8::EpiIn E{PROJ + C_CH, INC, 1 << 20, (const LAS float*)(F.lds + RSTD_OFF), ((int)blockIdx.x & 7) * 2048, -1, -1, KC, VC, AIN(4) + l * HD, rope, (LAS float*)(F.lds + XT_OFF), 13, (unsigned char*)(ws + WS_G8), 1 << 20, KC8, KN8, -1, -1, nullptr};
#ifndef NO_P1
            pg8::gemm_phase<pg8::EpiIn, pg8::StaticOrder, true, true>(F.lds + RING_OFF, g, S, E, F.wave);
#endif
            { LAS float* rt_ = (LAS float*)(F.lds + RSTD_OFF); const int rb_ = ((int)blockIdx.x & 7) * 2048;
              int t0_ = FTID; asm volatile("" : "+v"(t0_));
              for (int r_ = t0_; r_ < 2048; r_ += NWAVES * 64) rt_[r_] = __builtin_amdgcn_rsqf(SSX[rb_ + r_] * (1.0f / DM) + RMS_EPS) * ASC[rb_ + r_];
              __syncthreads(); }
            { pg8::Gemm g8{(const bf16*)XB8, (const bf16*)(ws + WS_WG8 + l * SZ_WG8), M, NI8, DM / 2}; pg8::GateOrder<10, 11> S8{(int)blockIdx.x};
              pg8::EpiInGate8<NQKV / 256> E8{pg8::EpiIn{PROJ, INC, 1 << 20, (const LAS float*)(F.lds + RSTD_OFF), ((int)blockIdx.x & 7) * 2048, C_GK / 256, C_GV / 256, KC, VC, AIN(4) + l * HD, rope, (LAS float*)(F.lds + XT_OFF), 13, (unsigned char*)(ws + WS_G8), 1 << 20, KC8, KN8, NA_K8 ? C_NAK / 256 : -1, NA_K8 ? C_NAV / 256 : -1, GQA_V8 ? VT8 : nullptr},
                                             (unsigned char*)(ws + WS_G8), (size_t)M * DM, WSC + l * NI8};
#ifndef NO_P1
              pg8::gemm_phase<pg8::EpiInGate8<NQKV / 256>, pg8::GateOrder<10, 11>, true, true, true>(F.lds + RING_OFF, g8, S8, E8, F.wave);
#endif
            }

        }
        GRID_BAR();
        }
        TS_E(1);
        TS_B(3);
        for (int rep_ = 0; rep_ < REP_P3; ++rep_) {
        {
#ifndef REP_CONV
#define REP_CONV 1
#endif
            for (int rc_ = 0; rc_ < REP_CONV; ++rc_)
            conv_rows(F, PROJ, AIN(5) + (size_t)l * 3 * 1024, AIN(6) + (size_t)l * 1024, BR8 ? ABR + 1024 : ABR + 2048, BR8 ? 2048 : 3072);
#ifndef NO_GQA
            bool gfix_; { const float* kg_ = AIN(4) + l * HD; const float* qg_ = AIN(3) + l * HD; const int ln_ = lane_id(); float gk_ = fmaxf(fabsf(kg_[ln_]), fabsf(kg_[64 + ln_])), gq_ = fmaxf(fabsf(qg_[ln_]), fabsf(qg_[64 + ln_]));
#pragma unroll
              for (int o_ = 1; o_ < 64; o_ <<= 1) { gk_ = fmaxf(gk_, shfl_xor_l(gk_, o_, ln_)); gq_ = fmaxf(gq_, shfl_xor_l(gq_, o_, ln_)); }
              gfix_ = __builtin_amdgcn_readfirstlane((int)(16.65f * gq_ * gk_ <= 40.0f && gq_ <= 30.0f && gk_ <= 30.0f)) != 0; }
            if (gfix_) {
            for (int i = 0;; ++i) { const int unit = i * F.G + F.vcu; if (unit >= 512) break;
                const int b = unit >> 8, h = (unit >> 5) & 7, qb = unit & 31;
                const size_t tok0 = (size_t)b * SEQ + (size_t)qb * 256;
                att::attn_unit<false, true, GQA_SDEPTH_FIXED, INC, HD, BR8 ? 4096 : 3072, GQA_K8 != 0, 128, BR8 != 0, (GQA_K8 != 0 && GQA_V8 != 0)>(PROJ + tok0 * INC + C_GQ + h * HD, GQA_K8 ? (const bf16*)(KC8 + (size_t)(b * 2 + (h >> 2)) * SEQ * 128) : KC + (size_t)(b * 2 + (h >> 2)) * SEQ * HD, (GQA_K8 && GQA_V8) ? (const bf16*)(VT8 + (size_t)(b * 2 + (h >> 2)) * HD * SEQ) : VC + (size_t)(b * 2 + (h >> 2)) * SEQ * HD,
                                                      BR8 ? (bf16*)((unsigned char*)ABR + tok0 * 4096 + 1024 + h * HD) : ABR + tok0 * 3072 + 1024 + h * HD, SEQ / 64, 0, 0, nullptr, AIN(3) + l * HD, rope, qb * 256, 0.f, (LAS char*)(F.lds + RING_OFF), F.wave); }
            } else {
            for (int i = 0;; ++i) { const int unit = i * F.G + F.vcu; if (unit >= 512) break;
                const int b = unit >> 8, h = (unit >> 5) & 7, qb = unit & 31;
                const size_t tok0 = (size_t)b * SEQ + (size_t)qb * 256;
                att::attn_unit<false, false, GQA_SDEPTH, INC, HD, BR8 ? 4096 : 3072, false, 128, BR8 != 0>(PROJ + tok0 * INC + C_GQ + h * HD, KC + (size_t)(b * 2 + (h >> 2)) * SEQ * HD, VC + (size_t)(b * 2 + (h >> 2)) * SEQ * HD,
                                                      BR8 ? (bf16*)((unsigned char*)ABR + tok0 * 4096 + 1024 + h * HD) : ABR + tok0 * 3072 + 1024 + h * HD, SEQ / 64, 0, 0, nullptr, AIN(3) + l * HD, rope, qb * 256, 0.f, (LAS char*)(F.lds + RING_OFF), F.wave); }
            }
#endif
#ifndef NO_NA
#ifndef REP_NA
#define REP_NA 1
#endif
            for (int rn_ = 0; rn_ < REP_NA; ++rn_)
            for (int i = 0;; ++i) { const int unit = i * F.G + F.vcu; if (unit >= 512) break;
                const int b = unit >> 8, h = (unit >> 5) & 7, rg = unit & 31;
                const size_t tok0 = (size_t)b * SEQ + (size_t)rg * 256; const int r0 = rg * 4, krow0 = min(max(r0 - 4, 0), 120);
                att::attn_unit<true, false, 1, INC, INC, BR8 ? 4096 : 3072, NA_K8 != 0, 1024, BR8 != 0>(PROJ + tok0 * INC + C_NAQ + h * HD, NA_K8 ? (const bf16*)(KN8 + (size_t)b * SEQ * 1024 + h * HD) : PROJ + (size_t)b * SEQ * INC + C_NAK + h * HD, PROJ + (size_t)b * SEQ * INC + C_NAV + h * HD,
                                                     BR8 ? (bf16*)((unsigned char*)ABR + tok0 * 4096 + h * HD) : ABR + tok0 * 3072 + h * HD, 12, krow0, r0, AIN(2) + (size_t)(l * 8 + h) * 15 * 31, nullptr, nullptr, 0, 0.f, (LAS char*)(F.lds + RING_OFF), F.wave); }
#endif
        }
        GRID_BAR();
        }
        TS_E(3);
        TS_B(4);
        for (int rep_ = 0; rep_ < REP_P4; ++rep_) {
        {
            pg8::StaticOrder S; S.init(M, DM, F.G, (int)blockIdx.x);
#if BR8
            pg8::Gemm g{ABR, (const bf16*)(ws + WS_WBR8 + (size_t)l * SZ_WBR8), M, DM, 2048}; pg8::EpiBranchK<8, 16, true> E{MRG, DM, (const unsigned char*)(ws + WS_G8), (size_t)M * DM, (const float*)(ws + WS_WSB) + l * DM};
            pg8::gemm_phase<pg8::EpiBranchK<8, 16, true>, pg8::StaticOrder, true, true, false, BR8_MIX>(F.lds + RING_OFF, g, S, E, F.wave);
#else
            pg8::Gemm g{ABR, (const bf16*)(ws + WS_WBR + (size_t)l * 3 * SZ_WBR), M, DM, 3072}; pg8::EpiBranchK<16, 32, false> E{MRG, DM, (const unsigned char*)(ws + WS_G8), (size_t)M * DM, nullptr};
            pg8::gemm_phase<pg8::EpiBranchK<16, 32, false>, pg8::StaticOrder, true, true>(F.lds + RING_OFF, g, S, E, F.wave);
#endif

        }
        GRID_BAR();
        }
        TS_E(4);
        TS_B(5);
        for (int rep_ = 0; rep_ < REP_P5; ++rep_) {
        {
            pg8::Gemm g{MRG, (const bf16*)(ws + WS_WOUT + l * SZ_WOUT), M, DM, DM}; pg8::StaticOrder S; S.init(M, DM, F.G, (int)blockIdx.x);
            pg8::EpiPlain E{Tb, DM};
            pg8::gemm_phase<pg8::EpiPlain, pg8::StaticOrder, true, true>(F.lds + RING_OFF, g, S, E, F.wave);
        }
        GRID_BAR();
        }
        TS_E(5);
        TS_B(6);
        {
            int ln = FLANE; asm volatile("" : "+v"(ln));
            if (l == 0) { for (int m = gw; m < M; m += 2 * NGW) { const int rows[2] = {m, m + NGW}; post_rows_bf<true, false, true, 2>(Tb, x_in, Hb, AIN(12) + l * DM, SSX, nullptr, XB8, ASC, rows, ln, Hb); } }
            else        { for (int m = gw; m < M; m += 2 * NGW) { const int rows[2] = {m, m + NGW}; post_rows_bf<false, false, true, 2>(Tb, nullptr, Hb, AIN(12) + l * DM, SSX, nullptr, XB8, ASC, rows, ln, Hb); } }
#ifdef REP_THIN
            for (int rt_ = 1; rt_ < REP_THIN; ++rt_) { GRID_BAR();
                for (int m = gw; m < M; m += 2 * NGW) { const int rows[2] = {m, m + NGW}; post_rows_bf<false, false, true, 2>(Tb, nullptr, Hb, AIN(12) + l * DM, (float*)(ws + WS_END + 96 * MiB), nullptr, (unsigned char*)(ws + WS_END + 64 * MiB), (float*)(ws + WS_END + 97 * MiB), rows, ln, (bf16*)(ws + WS_END)); } }
#endif
        }
        GRID_BAR();
        TS_E(6);
        TS_B(7);
        for (int rep_ = 0; rep_ < REP_P7; ++rep_) {
        {
            pg8::Gemm g{(const bf16*)XB8, (const bf16*)(ws + WS_WGU8 + l * SZ_WGU8), M, NGU, DM / 2};   pg8::StaticOrder S; S.init(M, NGU, F.G, (int)blockIdx.x);
            { LAS float* rt_ = (LAS float*)(F.lds + RSTD_OFF); const int rb_ = ((int)blockIdx.x & 7) * 2048;
              int t0_ = FTID; asm volatile("" : "+v"(t0_));
              for (int r_ = t0_; r_ < 2048; r_ += NWAVES * 64) rt_[r_] = __builtin_amdgcn_rsqf(SSX[rb_ + r_] * (1.0f / DM) + RMS_EPS) * ASC[rb_ + r_];
              __syncthreads(); }
            pg8::EpiGU8 E{ACT, FF, (const LAS float*)(F.lds + RSTD_OFF), ((int)blockIdx.x & 7) * 2048, WSCF + l * NGU};
            pg8::gemm_phase<pg8::EpiGU8, pg8::StaticOrder, true, true, true>(F.lds + RING_OFF, g, S, E, F.wave);
        }
        GRID_BAR();
        }
        TS_E(7);
        TS_B(8);
        for (int rep_ = 0; rep_ < REP_P8; ++rep_) {
        {
            pg8::Gemm g{ACT, (const bf16*)(ws + WS_WDN + l * SZ_WDN), M, DM, FF}; pg8::StaticOrder S; S.init(M, DM, F.G, (int)blockIdx.x);
            pg8::EpiPlain E{Tb, DM};
            pg8::gemm_phase<pg8::EpiPlain, pg8::StaticOrder, true, true>(F.lds + RING_OFF, g, S, E, F.wave);
        }
        GRID_BAR();
        }
        TS_E(8);
        TS_B(9);
        {
            int ln = FLANE; asm volatile("" : "+v"(ln));
            if (l + 1 < DEPTH) { for (int m = gw; m < M; m += 2 * NGW) { const int rows[2] = {m, m + NGW}; post_rows_bf<false, false, true, 2>(Tb, nullptr, Hb, AIN(14) + l * DM, SSX, nullptr, XB8, ASC, rows, ln, Hb); } }
            else               { for (int m = gw; m < M; m += 2 * NGW) { const int rows[2] = {m, m + NGW}; post_rows_bf<false, true, false, 2>(Tb, nullptr, Hb, AIN(14) + l * DM, nullptr, out, nullptr, nullptr, rows, ln, Hb); } }
        }
        if (l + 1 < DEPTH) GRID_BAR();
        TS_E(9);
    }
#ifdef PROBE_TS
    if (blockIdx.x == 0 && FTID == 0) __hip_atomic_store((unsigned*)(F.ctl + 8), F.MISC[17], RLX_AGENT);
    GRID_BAR();
    { const float dur_ = (float)__hip_atomic_load((unsigned*)(F.ctl + 8), RLX_AGENT) * 0.01f;
      const float delta = PROBE_TS_BASE + 0.1f * (floorf(__log2f(fmaxf(dur_, 51.f)) * 4.95948f + PROBE_TS_SCALE) - 28.0f);
      float* o_ = out; for (int i = blockIdx.x * (NWAVES * 64) + FTID; i < (1 << 20); i += F.G * NWAVES * 64) o_[i] += delta; }
#endif
#undef ws
#undef x_in
#undef out
#undef Hb
#undef PROJ
#undef ACT
#undef ABR
#undef MRG
#undef SSX
#undef XB8
#undef ASC
#undef WSC
#undef WSCF
#undef Tb
#undef KC
#undef VC
#undef rope
#undef VT8
#undef KN8
#undef KC8
}

extern "C" void kernel_launch(void* const* d_in, const int* in_sizes, int n_in, void* d_out, int out_size, void* d_ws, size_t ws_size, hipStream_t stream) {
    static int grid = 0;
    if (grid == 0) {
        if (n_in != 18 || in_sizes[0] != M * DM || out_size != M * DM || ws_size < WS_END) { fprintf(stderr, "kernel_launch: shape mismatch: n_in %d in0 %d out %d ws %zu (need >= %zu)\n", n_in, n_in > 0 ? in_sizes[0] : -1, out_size, ws_size, (size_t)WS_END); grid = -1; return; }
        int dev = 0, cus = 0, per_cu = 0;
        if (hipGetDevice(&dev) != hipSuccess || hipDeviceGetAttribute(&cus, hipDeviceAttributeMultiprocessorCount, dev) != hipSuccess) { fprintf(stderr, "kernel_launch: device query failed\n"); grid = -1; return; }
        if (hipFuncSetAttribute((const void*)mega_fwd, hipFuncAttributeMaxDynamicSharedMemorySize, LDS_BYTES) != hipSuccess) { fprintf(stderr, "kernel_launch: hipFuncSetAttribute failed\n"); grid = -1; return; }
        if (hipOccupancyMaxActiveBlocksPerMultiprocessor(&per_cu, (const void*)mega_fwd, NWAVES * 64, LDS_BYTES) != hipSuccess || per_cu < 1) { fprintf(stderr, "kernel_launch: occupancy query reports %d workgroups per CU\n", per_cu); }
        (void)hipGetLastError();
        if (cus != 256) { fprintf(stderr, "kernel_launch: built for a 256-CU device (the fused epilogues' unit order needs exactly 256 workgroups); this device has %d\n", cus); grid = -1; return; }
        grid = cus;
    }
    if (grid < 0) return;
    if (hipMemsetAsync((char*)d_ws + WS_CTL, 0, CTL_ZERO_BYTES, stream) != hipSuccess) { fprintf(stderr, "kernel_launch: memset failed\n"); return; }
    Args a{};
    for (int i = 0; i < 18; ++i) a.in[i] = (const float*)d_in[i];
    a.out = (float*)d_out; a.ws = (unsigned char*)d_ws;
    hipLaunchKernelGGL(mega_fwd, dim3(grid), dim3(NWAVES * 64), LDS_BYTES, stream, a);
    const hipError_t le = hipPeekAtLastError();
    if (le != hipSuccess) fprintf(stderr, "kernel_launch: launch failed: %s\n", hipGetErrorName(le));
}
```
